# Optimizing an MI355X kernel written in HIP

```python
import math
import jax, jax.numpy as jnp
from jax import lax
import numpy as np

D_MODEL = 1024
BATCH = 8
SEQ = 2048
DEPTH = 2
DEC_BATCH = 128
DEC_SEQ = 8
PAST_LEN = 16384
PAGE_SIZE = 128

N_AB = (DEPTH + 1) // 2
N_CL = DEPTH // 2
D_A = D_MODEL // 2
S5_GROUP = 16
G_A = D_A // S5_GROUP
P_STATE = 64
D_B = D_MODEL // 2
H_B = 4
DK_B = 128
DV_B = D_B // H_B
CONV_W = 4
CHUNK = 64
AB_SPLITS = (D_A, D_A + H_B * DK_B, D_A + 2 * H_B * DK_B, D_A + 2 * H_B * DK_B + D_B,
             D_A + 2 * H_B * DK_B + D_B + H_B, D_A + 2 * H_B * DK_B + D_B + 2 * H_B)
D_IN_AB = AB_SPLITS[-1] + D_B
N_HEAD_C = 64
H_C = D_MODEL // N_HEAD_C
LORA_DECAY = 64
LORA_AAA = 64
LORA_GATE = 160
RWKV_GN_EPS = 64e-5
D_FF = ((-(-8 * D_MODEL // 3) + 255) // 256) * 256
NORM_EPS = 1e-6

kernel_name = "hybrid_s5_gdn_rwkv7_decode_step"


def rmsnorm(x, w):
    xf = x.astype(jnp.float32)
    y = xf * lax.rsqrt(jnp.mean(xf * xf, axis=-1, keepdims=True) + NORM_EPS)
    return (y * w.astype(jnp.float32)).astype(x.dtype)


def l2norm(x):
    xf = x.astype(jnp.float32)
    return xf * lax.rsqrt(jnp.sum(xf * xf, axis=-1, keepdims=True) + NORM_EPS)


def swiglu(h, w_gate, w_up, w_down):
    return (jax.nn.silu(h @ w_gate) * (h @ w_up)) @ w_down


def s5_mixer(u, h0_re, h0_im, lam_re, lam_im, log_step, b_re, b_im, c_re, c_im, d_skip, w_glu):
    bsz, seq = u.shape[0], u.shape[1]
    f32 = jnp.float32
    uf = u.astype(f32).reshape(bsz, seq, G_A, S5_GROUP)
    lr, li = lam_re.astype(f32), lam_im.astype(f32)
    dt = jnp.exp(log_step.astype(f32))[:, None]
    mag = jnp.exp(lr * dt)
    ab_re, ab_im = mag * jnp.cos(li * dt), mag * jnp.sin(li * dt)
    den = lr * lr + li * li
    nr, ni = ab_re - 1.0, ab_im
    cr, ci = (nr * lr + ni * li) / den, (ni * lr - nr * li) / den
    b_re, b_im = b_re.astype(f32), b_im.astype(f32)
    bb_re = cr[..., None] * b_re - ci[..., None] * b_im
    bb_im = cr[..., None] * b_im + ci[..., None] * b_re
    bu_re = jnp.einsum("gpc,blgc->blgp", bb_re, uf)
    bu_im = jnp.einsum("gpc,blgc->blgp", bb_im, uf)
    h0r, h0i = h0_re.astype(f32), h0_im.astype(f32)
    bu_re = bu_re.at[:, 0].add(ab_re * h0r - ab_im * h0i)
    bu_im = bu_im.at[:, 0].add(ab_re * h0i + ab_im * h0r)
    a_re = jnp.broadcast_to(ab_re, bu_re.shape)
    a_im = jnp.broadcast_to(ab_im, bu_im.shape)

    def combine(e1, e2):
        a1r, a1i, b1r, b1i = e1
        a2r, a2i, b2r, b2i = e2
        return (a1r * a2r - a1i * a2i, a1r * a2i + a1i * a2r,
                a2r * b1r - a2i * b1i + b2r, a2r * b1i + a2i * b1r + b2i)

    _, _, xr, xi = lax.associative_scan(combine, (a_re, a_im, bu_re, bu_im), axis=1)
    y = (jnp.einsum("gcp,blgp->blgc", c_re.astype(f32), xr)
         - jnp.einsum("gcp,blgp->blgc", c_im.astype(f32), xi)
         + d_skip.astype(f32).reshape(G_A, S5_GROUP) * uf).reshape(bsz, seq, D_A)
    yg = jax.nn.gelu(y)
    out = yg * jax.nn.sigmoid(yg @ w_glu.astype(f32))
    return out.astype(u.dtype), xr[:, -1], xi[:, -1]


def causal_conv_silu(x, buf, w):
    seq = x.shape[1]
    xp = jnp.concatenate([buf.astype(x.dtype), x], axis=1)
    y = sum(xp[:, j:j + seq] * w[j] for j in range(CONV_W))
    return jax.nn.silu(y), xp[:, -(CONV_W - 1):]


def gated_delta_chunked(q, k, v, g, beta, s0):
    bsz, seq, nh, dk = q.shape
    dv = v.shape[-1]
    n_chunks = -(-seq // CHUNK)
    pad = n_chunks * CHUNK - seq

    def blocks(t):
        t = t.astype(jnp.float32)
        t = jnp.pad(t, [(0, 0), (0, pad)] + [(0, 0)] * (t.ndim - 2))
        t = t.reshape((bsz, n_chunks, CHUNK) + t.shape[2:])
        return jnp.swapaxes(jnp.moveaxis(t, 3, 2), 0, 1)

    qb = blocks(q) * (dk ** -0.5)
    kb, vb, gb, bb = blocks(k), blocks(v), blocks(g), blocks(beta)
    gc = jnp.cumsum(gb, axis=-1)
    idx = jnp.arange(CHUNK)
    causal = idx[:, None] >= idx[None, :]
    strict = idx[:, None] > idx[None, :]
    decay = jnp.exp(jnp.where(causal, gc[..., :, None] - gc[..., None, :], -jnp.inf))
    k_beta = kb * bb[..., None]
    v_beta = vb * bb[..., None]
    lmat = jnp.where(strict, jnp.einsum("nbhid,nbhjd->nbhij", k_beta, kb) * decay, 0.0)
    eye = jnp.eye(CHUNK, dtype=jnp.float32)
    tmat = lax.linalg.triangular_solve(eye + lmat, jnp.broadcast_to(eye, lmat.shape),
                                       left_side=True, lower=True)
    u_c = tmat @ v_beta
    w_c = tmat @ (k_beta * jnp.exp(gc)[..., None])

    def step(state, inp):
        qc, kc, uc, wc, gcc, dc = inp
        attn = jnp.einsum("bhid,bhjd->bhij", qc, kc) * dc
        v_new = uc - jnp.einsum("bhcd,bhdv->bhcv", wc, state)
        o = (jnp.einsum("bhcd,bhdv->bhcv", qc * jnp.exp(gcc)[..., None], state)
             + jnp.einsum("bhij,bhjv->bhiv", attn, v_new))
        g_last = gcc[..., -1]
        state = (state * jnp.exp(g_last)[..., None, None]
                 + jnp.einsum("bhcd,bhcv->bhdv", kc * jnp.exp(g_last[..., None] - gcc)[..., None], v_new))
        return state, o

    s_fin, o = lax.scan(step, s0.astype(jnp.float32), (qb, kb, u_c, w_c, gc, decay))
    o = jnp.transpose(o, (1, 0, 3, 2, 4)).reshape(bsz, n_chunks * CHUNK, nh, dv)[:, :seq]
    return o, s_fin


def gdn_mixer(q, k, v, b_raw, a_raw, z, s0, conv0, conv_w, a_log, dt_bias, norm_w):
    bsz, seq = q.shape[0], q.shape[1]
    qkv, conv_new = causal_conv_silu(jnp.concatenate([q, k, v], axis=-1), conv0, conv_w)
    q, k, v = jnp.split(qkv, (H_B * DK_B, 2 * H_B * DK_B), axis=-1)
    q = l2norm(q.reshape(bsz, seq, H_B, DK_B))
    k = l2norm(k.reshape(bsz, seq, H_B, DK_B))
    v = v.reshape(bsz, seq, H_B, DV_B)
    beta = jax.nn.sigmoid(b_raw.astype(jnp.float32))
    g = -jnp.exp(a_log.astype(jnp.float32)) * jax.nn.softplus(
        a_raw.astype(jnp.float32) + dt_bias.astype(jnp.float32))
    o, s_fin = gated_delta_chunked(q, k, v, g, beta, s0)
    o = rmsnorm(o, norm_w) * jax.nn.silu(z.astype(jnp.float32).reshape(bsz, seq, H_B, DV_B))
    return o.reshape(bsz, seq, D_B).astype(q.dtype if q.dtype != jnp.float32 else z.dtype), s_fin, conv_new


def rwkv7_scan(r, decay, k, v, a, b, s0):
    def step(state, inp):
        r_t, w_t, k_t, v_t, a_t, b_t = inp
        sa = jnp.einsum("bhvk,bhk->bhv", state, a_t)
        state = (state * w_t[:, :, None, :] + sa[..., None] * b_t[:, :, None, :]
                 + v_t[..., None] * k_t[:, :, None, :])
        return state, jnp.einsum("bhvk,bhk->bhv", state, r_t)

    xs = tuple(jnp.swapaxes(t.astype(jnp.float32), 0, 1) for t in (r, decay, k, v, a, b))
    s_fin, ys = lax.scan(step, s0.astype(jnp.float32), xs)
    return jnp.swapaxes(ys, 0, 1), s_fin


def rwkv7_mixer(x, shift0, s0, maa, w_r, w_k, w_v, w_o, w0, w1, w2, a0, a1, a2, g1, g2,
                k_k, k_a, r_k, ln_w, ln_b):
    bsz, seq, _ = x.shape
    x_prev = jnp.concatenate([shift0[:, None].astype(x.dtype), x[:, :-1]], axis=1)
    xx = x_prev - x
    xr, xw, xk, xv, xa, xg = (x + xx * maa[j] for j in range(6))
    r = xr @ w_r
    k = xk @ w_k
    v = xv @ w_v
    w = -jax.nn.softplus(-(w0 + jnp.tanh(xw @ w1) @ w2).astype(jnp.float32)) - 0.5
    a = jax.nn.sigmoid((a0 + (xa @ a1) @ a2).astype(jnp.float32))
    g = jax.nn.sigmoid(xg @ g1) @ g2
    heads = lambda t: t.reshape(bsz, seq, H_C, N_HEAD_C)
    kk = l2norm(heads(k * k_k))
    k = k.astype(jnp.float32) * (1.0 + (a - 1.0) * k_a.astype(jnp.float32))
    decay = jnp.exp(-jnp.exp(w))
    rh, kh, vh, ah = heads(r).astype(jnp.float32), heads(k), heads(v).astype(jnp.float32), heads(a)
    y, s_fin = rwkv7_scan(rh, heads(decay), kh, vh, -kk, kk * ah, s0)
    mu = jnp.mean(y, axis=-1, keepdims=True)
    var = jnp.mean(jnp.square(y - mu), axis=-1, keepdims=True)
    y = (y - mu) * lax.rsqrt(var + RWKV_GN_EPS)
    y = y * ln_w.astype(jnp.float32).reshape(H_C, N_HEAD_C) + ln_b.astype(jnp.float32).reshape(H_C, N_HEAD_C)
    y = y + jnp.sum(rh * kh * r_k.astype(jnp.float32), axis=-1, keepdims=True) * vh
    out = (y.reshape(bsz, seq, D_MODEL) * g.astype(jnp.float32)).astype(x.dtype) @ w_o
    return out, s_fin, x[:, -1]


def trunk(x, s5_re0, s5_im0, gdn_s0, gdn_conv0, rw_s0, rw_shift0, prm):
    s5_re_n, s5_im_n, gdn_s_n, gdn_conv_n, rw_s_n, rw_shift_n = [], [], [], [], [], []
    for layer in range(DEPTH):
        i = layer // 2
        h = rmsnorm(x, prm["norm_mix"][layer])
        if layer % 2 == 0:
            proj = h @ prm["ab_w_in"][i]
            u_a, q, k, v, b_raw, a_raw, z = jnp.split(proj, AB_SPLITS, axis=-1)
            y_a, hr, hi = s5_mixer(u_a, s5_re0[i], s5_im0[i], prm["s5_lambda_re"][i], prm["s5_lambda_im"][i],
                                   prm["s5_log_step"][i], prm["s5_B_re"][i], prm["s5_B_im"][i],
                                   prm["s5_C_re"][i], prm["s5_C_im"][i], prm["s5_D"][i], prm["s5_w_glu"][i])
            y_b, s_b, conv_b = gdn_mixer(q, k, v, b_raw, a_raw, z, gdn_s0[i], gdn_conv0[i], prm["gdn_conv_w"][i],
                                         prm["gdn_A_log"][i], prm["gdn_dt_bias"][i], prm["gdn_norm_w"][i])
            mix = jnp.concatenate([y_a, y_b.astype(y_a.dtype)], axis=-1) @ prm["ab_w_out"][i]
            s5_re_n.append(hr)
            s5_im_n.append(hi)
            gdn_s_n.append(s_b)
            gdn_conv_n.append(conv_b)
        else:
            mix, s_c, shift_c = rwkv7_mixer(
                h, rw_shift0[i], rw_s0[i], prm["rw_maa"][i], prm["rw_w_r"][i], prm["rw_w_k"][i], prm["rw_w_v"][i],
                prm["rw_w_o"][i], prm["rw_w0"][i], prm["rw_w1"][i], prm["rw_w2"][i], prm["rw_a0"][i], prm["rw_a1"][i],
                prm["rw_a2"][i], prm["rw_g1"][i], prm["rw_g2"][i], prm["rw_k_k"][i], prm["rw_k_a"][i],
                prm["rw_r_k"][i], prm["rw_ln_w"][i], prm["rw_ln_b"][i])
            rw_s_n.append(s_c)
            rw_shift_n.append(shift_c)
        x = x + mix.astype(x.dtype)
        h = rmsnorm(x, prm["norm_ffn"][layer])
        x = x + swiglu(h, prm["ffn_w_gate"][layer], prm["ffn_w_up"][layer], prm["ffn_w_down"][layer]).astype(x.dtype)
    y = rmsnorm(x, prm["norm_final"])
    return (y, jnp.stack(s5_re_n), jnp.stack(s5_im_n), jnp.stack(gdn_s_n), jnp.stack(gdn_conv_n),
            jnp.stack(rw_s_n), jnp.stack(rw_shift_n))


def setup_inputs(seed: int = 0) -> dict:
    key = jax.random.key(seed)
    ks = jax.random.split(key, 64)
    counter = [0]

    def nxt():
        counter[0] += 1
        return ks[counter[0] - 1]

    def nrm(shape, scale=1.0):
        return scale * jax.random.normal(nxt(), shape, jnp.float32)

    def unif(shape, lo, hi):
        return jax.random.uniform(nxt(), shape, jnp.float32, lo, hi)

    D = D_MODEL
    inp = {}
    inp["x_prompt"] = nrm((BATCH, SEQ, D))
    inp["x_sample"] = nrm((DEC_BATCH, DEC_SEQ, D))
    inp["state_s5_re"] = nrm((N_AB, DEC_BATCH, G_A, P_STATE), 0.3)
    inp["state_s5_im"] = nrm((N_AB, DEC_BATCH, G_A, P_STATE), 0.3)
    inp["state_gdn"] = nrm((N_AB, DEC_BATCH, H_B, DK_B, DV_B), 0.1)
    inp["state_gdn_conv"] = nrm((N_AB, DEC_BATCH, CONV_W - 1, 2 * H_B * DK_B + D_B))
    inp["state_rwkv"] = nrm((N_CL, DEC_BATCH, H_C, N_HEAD_C, N_HEAD_C), 0.3)
    inp["state_rwkv_shift"] = nrm((N_CL, DEC_BATCH, D))
    inp["norm_mix"] = 1.0 + nrm((DEPTH, D), 0.02)
    inp["norm_ffn"] = 1.0 + nrm((DEPTH, D), 0.02)
    inp["norm_final"] = 1.0 + nrm((D,), 0.02)
    inp["ffn_w_gate"] = nrm((DEPTH, D, D_FF), D ** -0.5)
    inp["ffn_w_up"] = nrm((DEPTH, D, D_FF), D ** -0.5)
    inp["ffn_w_down"] = nrm((DEPTH, D_FF, D), D_FF ** -0.5)
    inp["ab_w_in"] = nrm((N_AB, D, D_IN_AB), D ** -0.5)
    inp["ab_w_out"] = nrm((N_AB, D_A + D_B, D), (D_A + D_B) ** -0.5)
    inp["s5_lambda_re"] = -0.5 * jnp.exp(nrm((N_AB, G_A, P_STATE), 0.05))
    inp["s5_lambda_im"] = jnp.pi * jnp.arange(P_STATE, dtype=jnp.float32) + nrm((N_AB, G_A, P_STATE), 0.01)
    inp["s5_log_step"] = unif((N_AB, G_A), math.log(1e-3), math.log(1e-1))
    inp["s5_B_re"] = nrm((N_AB, G_A, P_STATE, S5_GROUP), (2 * S5_GROUP) ** -0.5)
    inp["s5_B_im"] = nrm((N_AB, G_A, P_STATE, S5_GROUP), (2 * S5_GROUP) ** -0.5)
    inp["s5_C_re"] = nrm((N_AB, G_A, S5_GROUP, P_STATE), (2 * P_STATE) ** -0.5)
    inp["s5_C_im"] = nrm((N_AB, G_A, S5_GROUP, P_STATE), (2 * P_STATE) ** -0.5)
    inp["s5_D"] = nrm((N_AB, D_A))
    inp["s5_w_glu"] = nrm((N_AB, D_A, D_A), D_A ** -0.5)
    inp["gdn_conv_w"] = nrm((N_AB, CONV_W, 2 * H_B * DK_B + D_B), 0.5)
    inp["gdn_A_log"] = jnp.log(unif((N_AB, H_B), 1.0, 16.0))
    dt = jnp.exp(unif((N_AB, H_B), math.log(1e-3), math.log(1e-1)))
    inp["gdn_dt_bias"] = dt + jnp.log(-jnp.expm1(-dt))
    inp["gdn_norm_w"] = 1.0 + nrm((N_AB, DV_B), 0.05)
    inp["rw_maa"] = unif((N_CL, 6, D), 0.0, 1.0)
    inp["rw_w_r"] = nrm((N_CL, D, D), D ** -0.5)
    inp["rw_w_k"] = nrm((N_CL, D, D), D ** -0.5)
    inp["rw_w_v"] = nrm((N_CL, D, D), D ** -0.5)
    inp["rw_w_o"] = nrm((N_CL, D, D), D ** -0.5)
    ramp = jnp.arange(D, dtype=jnp.float32) / (D - 1)
    inp["rw_w0"] = -6.0 + 5.0 * ramp ** 0.85 + nrm((N_CL, D), 0.1)
    inp["rw_w1"] = nrm((N_CL, D, LORA_DECAY), D ** -0.5)
    inp["rw_w2"] = nrm((N_CL, LORA_DECAY, D), 0.1 * LORA_DECAY ** -0.5)
    inp["rw_a0"] = nrm((N_CL, D), 0.1)
    inp["rw_a1"] = nrm((N_CL, D, LORA_AAA), D ** -0.5)
    inp["rw_a2"] = nrm((N_CL, LORA_AAA, D), 0.1 * LORA_AAA ** -0.5)
    inp["rw_g1"] = nrm((N_CL, D, LORA_GATE), D ** -0.5)
    inp["rw_g2"] = nrm((N_CL, LORA_GATE, D), LORA_GATE ** -0.5)
    inp["rw_k_k"] = 0.85 + nrm((N_CL, D), 0.02)
    inp["rw_k_a"] = 1.0 + nrm((N_CL, D), 0.02)
    inp["rw_r_k"] = nrm((N_CL, H_C, N_HEAD_C), 0.1)
    inp["rw_ln_w"] = 1.0 + nrm((N_CL, D), 0.05)
    inp["rw_ln_b"] = nrm((N_CL, D), 0.02)
    return inp


def reference(x_prompt, x_sample, state_s5_re, state_s5_im, state_gdn, state_gdn_conv, state_rwkv,
              state_rwkv_shift, norm_mix, norm_ffn, norm_final, ffn_w_gate, ffn_w_up, ffn_w_down,
              ab_w_in, ab_w_out, s5_lambda_re, s5_lambda_im, s5_log_step, s5_B_re, s5_B_im, s5_C_re, s5_C_im,
              s5_D, s5_w_glu, gdn_conv_w, gdn_A_log, gdn_dt_bias, gdn_norm_w, rw_maa, rw_w_r, rw_w_k, rw_w_v,
              rw_w_o, rw_w0, rw_w1, rw_w2, rw_a0, rw_a1, rw_a2, rw_g1, rw_g2, rw_k_k, rw_k_a, rw_r_k,
              rw_ln_w, rw_ln_b):
    prm = dict(norm_mix=norm_mix, norm_ffn=norm_ffn, norm_final=norm_final, ffn_w_gate=ffn_w_gate,
               ffn_w_up=ffn_w_up, ffn_w_down=ffn_w_down, ab_w_in=ab_w_in, ab_w_out=ab_w_out,
               s5_lambda_re=s5_lambda_re, s5_lambda_im=s5_lambda_im, s5_log_step=s5_log_step,
               s5_B_re=s5_B_re, s5_B_im=s5_B_im, s5_C_re=s5_C_re, s5_C_im=s5_C_im, s5_D=s5_D, s5_w_glu=s5_w_glu,
               gdn_conv_w=gdn_conv_w, gdn_A_log=gdn_A_log, gdn_dt_bias=gdn_dt_bias, gdn_norm_w=gdn_norm_w,
               rw_maa=rw_maa, rw_w_r=rw_w_r, rw_w_k=rw_w_k, rw_w_v=rw_w_v, rw_w_o=rw_w_o, rw_w0=rw_w0,
               rw_w1=rw_w1, rw_w2=rw_w2, rw_a0=rw_a0, rw_a1=rw_a1, rw_a2=rw_a2, rw_g1=rw_g1, rw_g2=rw_g2,
               rw_k_k=rw_k_k, rw_k_a=rw_k_a, rw_r_k=rw_r_k, rw_ln_w=rw_ln_w, rw_ln_b=rw_ln_b)
    dt = x_prompt.dtype
    (y_prompt, p_s5_re, p_s5_im, p_gdn, p_gdn_conv, p_rwkv, p_rwkv_shift) = trunk(
        x_prompt,
        jnp.zeros((N_AB, BATCH) + state_s5_re.shape[2:], jnp.float32),
        jnp.zeros((N_AB, BATCH) + state_s5_im.shape[2:], jnp.float32),
        jnp.zeros((N_AB, BATCH) + state_gdn.shape[2:], jnp.float32),
        jnp.zeros((N_AB, BATCH) + state_gdn_conv.shape[2:], dt),
        jnp.zeros((N_CL, BATCH) + state_rwkv.shape[2:], jnp.float32),
        jnp.zeros((N_CL, BATCH) + state_rwkv_shift.shape[2:], dt),
        prm)
    (y_sample, s_s5_re, s_s5_im, s_gdn, s_gdn_conv, s_rwkv, s_rwkv_shift) = trunk(
        x_sample, state_s5_re, state_s5_im, state_gdn, state_gdn_conv, state_rwkv, state_rwkv_shift, prm)
    return (y_prompt, y_sample, p_s5_re, p_s5_im, p_gdn, p_gdn_conv, p_rwkv, p_rwkv_shift,
            s_s5_re, s_s5_im, s_gdn, s_gdn_conv, s_rwkv, s_rwkv_shift)
```

```cpp
#include <hip/hip_runtime.h>
#include <hip/hip_cooperative_groups.h>
#include <cstdio>
#include <cstdint>
namespace cg = cooperative_groups;

#define DI __device__ __forceinline__
#define LAS __attribute__((address_space(3)))
typedef unsigned short bf16_t;
typedef short bf16x8 __attribute__((ext_vector_type(8)));
typedef float f32x4 __attribute__((ext_vector_type(4)));
typedef float f32x2 __attribute__((ext_vector_type(2)));
typedef unsigned u32x4 __attribute__((ext_vector_type(4)));
typedef unsigned u32x2 __attribute__((ext_vector_type(2)));
typedef __bf16 bf16x2_t __attribute__((ext_vector_type(2)));

constexpr int D = 1024, MP = 16384, MS = 1024, M = MP + MS, SEQP = 2048, SEQS = 8, NBP = 8, NBS = 128, NSEQ = NBP + NBS;
constexpr int DFF = 2816, NPROJ = 2816  , NRW1 = 3584;
constexpr float NORM_EPS = 1e-6f;
constexpr size_t O_Y = 0;
constexpr size_t O_P_S5RE = (size_t)M * D, O_P_S5IM = O_P_S5RE + 8 * 32 * 64, O_P_GDN = O_P_S5IM + 8 * 32 * 64, O_P_CONV = O_P_GDN + (size_t)8 * 4 * 128 * 128,
                 O_P_RWKV = O_P_CONV + 8 * 3 * 1536, O_P_SHIFT = O_P_RWKV + (size_t)8 * 16 * 64 * 64, O_S_S5RE = O_P_SHIFT + 8 * 1024, O_S_S5IM = O_S_S5RE + 128 * 32 * 64,
                 O_S_GDN = O_S_S5IM + 128 * 32 * 64, O_S_CONV = O_S_GDN + (size_t)128 * 4 * 128 * 128, O_S_RWKV = O_S_CONV + 128 * 3 * 1536,
                 O_S_SHIFT = O_S_RWKV + (size_t)128 * 16 * 64 * 64, O_END = O_S_SHIFT + 128 * 1024;
constexpr size_t MiB = 1u << 20;
constexpr size_t WS_W_IN = 1 * MiB, WS_W_GLU = WS_W_IN + (size_t)NPROJ * 1024 * 2, WS_W_OUT = WS_W_GLU + 512 * 512 * 2, WS_W_GU0 = WS_W_OUT + 1024 * 1024 * 2,
                 WS_W_DN0 = WS_W_GU0 + (size_t)5632 * 1024 * 2, WS_W_GU1 = WS_W_DN0 + (size_t)1024 * 2816 * 2, WS_W_DN1 = WS_W_GU1 + (size_t)5632 * 1024 * 2,
                 WS_W_RW1 = WS_W_DN1 + (size_t)1024 * 2816 * 2, WS_W_RW2 = WS_W_RW1 + (size_t)NRW1 * 2048 * 2, WS_W_G2 = WS_W_RW2 + 2048 * 128 * 2,
                 WS_W_O = WS_W_G2 + 1024 * 256 * 2, WS_W_END = WS_W_O + 1024 * 1024 * 2;
static_assert(WS_W_END <= 60 * MiB, "weights");
constexpr size_t WS_HB = 60 * MiB;
constexpr size_t WS_PROJ = 94 * MiB;
constexpr size_t WS_CAT = 188 * MiB;
constexpr size_t WS_LD = 60 * MiB, WS_AA = 94 * MiB;
constexpr size_t WS_R = 128 * MiB, WS_K = 162 * MiB, WS_V = 196 * MiB, WS_LMWA = 230 * MiB, WS_LMG = 235 * MiB, WS_END = 256 * MiB;
static_assert(WS_V - WS_K == WS_K - WS_R, "rkv spacing");
static_assert(WS_LMG + (size_t)M * 256 * 2 <= WS_END && WS_LMWA + (size_t)M * 128 * 2 <= WS_LMG && WS_CAT + (size_t)M * 1024 * 2 <= WS_END, "ws map");
constexpr int LDS_BYTES = 147456;

DI unsigned pk2(float a, float b) { f32x2 v = {a, b}; return __builtin_bit_cast(unsigned, __builtin_convertvector(v, bf16x2_t)); }
DI float bf_lo(unsigned u) { return __builtin_bit_cast(float, u << 16); }
DI float bf_hi(unsigned u) { return __builtin_bit_cast(float, u & 0xffff0000u); }
DI float bf1(bf16_t h) { return __builtin_bit_cast(float, (unsigned)h << 16); }
DI bf16_t f2bf(float f) { return (bf16_t)(pk2(f, 0.f) & 0xffffu); }
DI float sigm(float x) { return __builtin_amdgcn_rcpf(1.f + __expf(-x)); }
DI float siluf(float x) { return x * sigm(x); }
DI float tanh_f(float x) { const float e = __expf(2.f * x); return 1.f - 2.f * __builtin_amdgcn_rcpf(e + 1.f); }
DI float gelu_t(float x) { const float u = 0.7978845608f * (x + 0.044715f * x * x * x); return 0.5f * x * (1.f + tanh_f(u)); }
DI float softplusf(float x) { return fmaxf(x, 0.f) + __logf(1.f + __expf(-fabsf(x))); }
DI float wave_sum(float v) {
#pragma unroll
    for (int o = 1; o < 64; o <<= 1) v += __shfl_xor(v, o);
    return v;
}
template <int CTRL> DI float dppf(float v) { return __builtin_bit_cast(float, __builtin_amdgcn_update_dpp(0, __builtin_bit_cast(int, v), CTRL, 0xF, 0xF, true)); }
DI float sum16(float v) { v += dppf<0xB1>(v); v += dppf<0x4E>(v); v += dppf<0x141>(v); v += dppf<0x140>(v); return v; }
DI float sum8_dpp(float v) { v += dppf<0xB1>(v); v += dppf<0x4E>(v); v += dppf<0x141>(v); return v; }
DI void unpack8(const u32x4 w, float (&x)[8]) { x[0] = bf_lo(w.x); x[1] = bf_hi(w.x); x[2] = bf_lo(w.y); x[3] = bf_hi(w.y); x[4] = bf_lo(w.z); x[5] = bf_hi(w.z); x[6] = bf_lo(w.w); x[7] = bf_hi(w.w); }
DI u32x4 pack8(const float (&x)[8]) { u32x4 w; w.x = pk2(x[0], x[1]); w.y = pk2(x[2], x[3]); w.z = pk2(x[4], x[5]); w.w = pk2(x[6], x[7]); return w; }
DI int opaque_tid() { int t = threadIdx.x; asm volatile("" : "+v"(t)); return t; }
#define LBAR() do { asm volatile("s_waitcnt lgkmcnt(0)" ::: "memory"); __builtin_amdgcn_s_barrier(); asm volatile("" ::: "memory"); } while (0)
#define LDS_WAIT() asm volatile("s_waitcnt lgkmcnt(0)" ::: "memory")
#define MFMA16(a, b, c) __builtin_amdgcn_mfma_f32_16x16x32_bf16((a), (b), (c), 0, 0, 0)

namespace pg8 {
constexpr int BM = 256, BK = 64, HALF = 128, HTB = HALF * BK * 2, STAGE_BYTES = 8 * HTB, NXCD = 8, WGM = 8;
__host__ __device__ __forceinline__ int lds_byte(int r, int c) { const int st = (r >> 4) * 2 + (c >> 5), rr = r & 15, cc = c & 31, ob = rr * 64 + cc * 2; return st * 1024 + (ob ^ (((ob >> 9) & 1) << 5)); }
__host__ __device__ __forceinline__ void stage_rc(int b, int& R, int& C) { const int st = b / 1024, sb = b % 1024, swz = sb ^ (((sb >> 9) & 1) << 5); R = (st >> 1) * 16 + swz / 64; C = (st & 1) * 32 + (swz % 64) / 2; }
__host__ __device__ __forceinline__ int perm32(int rho) { const int n = rho >> 4, i = rho & 15; return 8 * (i >> 2) + 4 * n + (i & 3); }
struct Unit { int pm, pn, kofs, nt, atomic; };
struct Gemm { const bf16_t* A; const bf16_t* Bt; int M, N, K, lda, ldb; };
struct StaticOrder {
    int nM, nN, nwg, G, c, ntK, split;
    __host__ __device__ void init(int M_, int N_, int G_, int c_, int K_, int split_ = 0) { nM = M_ / BM; nN = N_ / BM; nwg = nM * nN; G = G_; c = c_; ntK = K_ / BK; split = split_; }
    __host__ __device__ bool next(int i, Unit& u) const {
        u.kofs = 0; u.nt = ntK; u.atomic = 0;
        if (split) {
            if (i == 0 && c < 16 * split) { const int un = c / split, sl = c - un * split; u.pm = 64 + (un >> 2); u.pn = un & 3; u.nt = ntK / split; u.kofs = sl * u.nt * BK; u.atomic = 1; return true; }
            return false;
        }
        const long L = (long)i * G + c; if (L >= nwg) return false;
        int wgid = (int)L; { const int q = nwg / NXCD, r = nwg % NXCD, xcd = wgid % NXCD, off = wgid / NXCD; wgid = (xcd < r ? xcd * (q + 1) : r * (q + 1) + (xcd - r) * q) + off; }
        const int nig = WGM * nN, gid = wgid / nig, fm = gid * WGM, gsz = (nM - fm) < WGM ? (nM - fm) : WGM;
        u.pm = fm + ((wgid % nig) % gsz); u.pn = (wgid % nig) / gsz; return true;
    }
};
template <class Epi, bool ALIGN_EPI, bool SPLITK = false>
DI void gemm_phase(LAS unsigned char* lds, const Gemm g, const StaticOrder& S, const Epi& E) {
    const int tid = opaque_tid(), wid = __builtin_amdgcn_readfirstlane(tid >> 6), lane = tid & 63, wr = wid >> 2, wc = wid & 3, fr = lane & 15, fq = lane >> 4;
    int K = g.K; asm volatile("" : "+s"(K)); int nt = K / BK;
    unsigned voffA[2], voffB[2];
#pragma unroll
    for (int i = 0; i < 2; ++i) { int R, C; stage_rc(tid * 16 + i * 8192, R, C); const int Rb = Epi::PERM ? ((R & ~31) + perm32(R & 31)) : R;
        voffA[i] = (unsigned)(R * g.lda + C) * 2u; voffB[i] = (unsigned)(Rb * g.ldb + C) * 2u; }
    const size_t kstep = (size_t)(BK * 2);
    const size_t hA = (size_t)HALF * g.lda * 2, hB = (size_t)HALF * g.ldb * 2, tA = 2 * hA, tB = 2 * hB;
    const unsigned ldsw = (unsigned)wid * 1024u;
    const int aoff = lds_byte(wr * 64 + fr, fq * 8), boff = lds_byte(wc * 32 + fr, fq * 8);
#define PG8_SA(b, h) (((b) * 2 + (h)) * HTB)
#define PG8_SB(b, h) ((4 + (b) * 2 + (h)) * HTB)
#define PG8_STAGE(bufoff, gbase, voff) do { _Pragma("unroll") for (int _i = 0; _i < 2; ++_i) \
        __builtin_amdgcn_global_load_lds((const unsigned*)((const char*)(gbase) + (voff)[_i]), (LAS unsigned*)(lds + (bufoff) + ldsw + _i * 8192), 16, 0, 0); } while (0)
#define PG8_LDA(dst, b, h) do { _Pragma("unroll") for (int m = 0; m < 4; ++m) _Pragma("unroll") for (int k = 0; k < 2; ++k) dst[m][k] = *(const LAS bf16x8*)(lds + PG8_SA(b, h) + aoff + m * 2048 + k * 1024); } while (0)
#define PG8_LDB(dst, b, h) do { _Pragma("unroll") for (int n = 0; n < 2; ++n) _Pragma("unroll") for (int k = 0; k < 2; ++k) dst[n][k] = *(const LAS bf16x8*)(lds + PG8_SB(b, h) + boff + n * 2048 + k * 1024); } while (0)
#define PG8_MMA(ai, bj, At, Bt) do { __builtin_amdgcn_s_setprio(1); _Pragma("unroll") for (int m = 0; m < 4; ++m) _Pragma("unroll") for (int n = 0; n < 2; ++n) _Pragma("unroll") for (int k = 0; k < 2; ++k) \
        acc[ai][bj][m][n] = __builtin_amdgcn_mfma_f32_16x16x32_bf16(Bt[n][k], At[m][k], acc[ai][bj][m][n], 0, 0, 0); __builtin_amdgcn_s_setprio(0); } while (0)
#define PG8_WAIT_V(n) asm volatile("s_waitcnt vmcnt(" #n ")" ::: "memory")
#define PG8_WAIT_L(n) asm volatile("s_waitcnt lgkmcnt(" #n ")" ::: "memory")
#define PG8_BAR __builtin_amdgcn_s_barrier()
#define PG8_SCHED __builtin_amdgcn_sched_barrier(0)
    Unit cur, nxt; int ui = 0;
    if (!S.next(0, cur)) return;
    f32x4 acc[2][2][4][2];
#pragma unroll
    for (int a = 0; a < 2; ++a)
#pragma unroll
        for (int b = 0; b < 2; ++b)
#pragma unroll
            for (int m = 0; m < 4; ++m)
#pragma unroll
                for (int n = 0; n < 2; ++n) acc[a][b][m][n] = (f32x4){0.f, 0.f, 0.f, 0.f};
    bf16x8 At[4][2], B0[2][2], B1[2][2];
    const char* cA = (const char*)g.A + (size_t)cur.pm * tA; const char* cB = (const char*)g.Bt + (size_t)cur.pn * tB;
    if constexpr (SPLITK) { cA += (size_t)cur.kofs * 2; cB += (size_t)cur.kofs * 2; nt = cur.nt; }
    PG8_STAGE(PG8_SB(0, 0), cB, voffB); PG8_STAGE(PG8_SB(0, 1), cB + hB, voffB); PG8_STAGE(PG8_SA(0, 0), cA, voffA); PG8_STAGE(PG8_SA(0, 1), cA + hA, voffA);
    if (wr == 1) PG8_BAR;
    PG8_WAIT_V(2); PG8_BAR;
    PG8_STAGE(PG8_SB(1, 0), cB + kstep, voffB); PG8_STAGE(PG8_SA(1, 0), cA + kstep, voffA); PG8_STAGE(PG8_SB(1, 1), cB + hB + kstep, voffB);
    PG8_WAIT_V(6); PG8_BAR;
    for (;;) {
        const bool has_next = S.next(ui + 1, nxt);
        const char* nA = has_next ? (const char*)g.A + (size_t)nxt.pm * tA + (SPLITK ? (size_t)nxt.kofs * 2 : (size_t)0) : cA; const char* nB = has_next ? (const char*)g.Bt + (size_t)nxt.pn * tB + (SPLITK ? (size_t)nxt.kofs * 2 : (size_t)0) : cB;
        for (int t = 0; t < nt; t += 2) {
            const bool last = (t == nt - 2);
            const char* a1 = cA + (size_t)(t + 1) * kstep;
            const char* a2 = last ? nA : cA + (size_t)(t + 2) * kstep; const char* b2 = last ? nB : cB + (size_t)(t + 2) * kstep;
            const char* a3 = a2 + kstep; const char* b3 = b2 + kstep;
            PG8_LDB(B0, 0, 0); PG8_LDB(B1, 0, 1); PG8_SCHED; PG8_LDA(At, 0, 0); PG8_STAGE(PG8_SA(1, 1), a1 + hA, voffA);
            PG8_WAIT_V(8); PG8_WAIT_L(0); PG8_BAR; PG8_MMA(0, 0, At, B0); PG8_MMA(0, 1, At, B1); PG8_BAR; PG8_SCHED;
            PG8_LDA(At, 0, 1); PG8_STAGE(PG8_SB(0, 0), b2, voffB); PG8_STAGE(PG8_SB(0, 1), b2 + hB, voffB); PG8_STAGE(PG8_SA(0, 0), a2, voffA);
            PG8_WAIT_V(8); PG8_WAIT_L(0); PG8_BAR; PG8_MMA(1, 0, At, B0); PG8_MMA(1, 1, At, B1); PG8_BAR; PG8_SCHED;
            PG8_LDB(B0, 1, 0); PG8_LDB(B1, 1, 1); PG8_SCHED; PG8_LDA(At, 1, 0); PG8_STAGE(PG8_SA(0, 1), a2 + hA, voffA);
            PG8_WAIT_V(8); PG8_WAIT_L(0); PG8_BAR; PG8_MMA(0, 0, At, B0); PG8_MMA(0, 1, At, B1); PG8_BAR; PG8_SCHED;
            PG8_LDA(At, 1, 1); PG8_STAGE(PG8_SB(1, 0), b3, voffB); PG8_STAGE(PG8_SB(1, 1), b3 + hB, voffB); PG8_STAGE(PG8_SA(1, 0), a3, voffA);
            PG8_WAIT_V(8); PG8_WAIT_L(0); PG8_BAR; PG8_MMA(1, 0, At, B0); PG8_MMA(1, 1, At, B1); PG8_BAR; PG8_SCHED;
        }
        if constexpr (ALIGN_EPI) { if (wr == 0) PG8_BAR; }
        E(acc, cur, wr, wc, fr, fq);
        if (!has_next) break;
#pragma unroll
        for (int a = 0; a < 2; ++a)
#pragma unroll
            for (int b = 0; b < 2; ++b)
#pragma unroll
                for (int m = 0; m < 4; ++m)
#pragma unroll
                    for (int n = 0; n < 2; ++n) acc[a][b][m][n] = (f32x4){0.f, 0.f, 0.f, 0.f};
        cur = nxt; cA = nA; cB = nB; ++ui; if constexpr (SPLITK) nt = cur.nt;
        if constexpr (ALIGN_EPI) { if (wr == 1) PG8_BAR; }
    }
    PG8_WAIT_V(0);
    if constexpr (!ALIGN_EPI) { if (wr == 0) PG8_BAR; }
    PG8_BAR;
#undef PG8_SA
#undef PG8_SB
#undef PG8_STAGE
#undef PG8_LDA
#undef PG8_LDB
#undef PG8_MMA
#undef PG8_WAIT_V
#undef PG8_WAIT_L
#undef PG8_BAR
#undef PG8_SCHED
}
}

enum { EP_BF16 = 0, EP_GLU, EP_RESID, EP_SWIGLU, EP_RW1, EP_RW2, EP_GATE, EP_ATOM };
template <int MODE> struct Epi {
    static constexpr bool PERM = (MODE != EP_RESID && MODE != EP_ATOM);
    bf16_t* O; int ldo;
    bf16_t *O2, *O3, *O4, *O5;
    const bf16_t* X; int ldx;
    const float* baseP; const float* baseS;
    float* out;
    const float *v0, *v1;
    int dry;
    DI void operator()(const f32x4 (&acc)[2][2][4][2], const pg8::Unit& u, int wr, int wc, int fr, int fq) const {
        const int row0 = u.pm * 256 + wr * 64 + fr;
        if constexpr (MODE == EP_ATOM) {
            const int slice = u.kofs / (u.nt * 64);
            float* op0 = out + ((size_t)slice * MS + (size_t)(row0 - MP)) * D + u.pn * 256 + wc * 32 + 4 * fq;
#pragma unroll
            for (int ai = 0; ai < 2; ++ai)
#pragma unroll
                for (int m = 0; m < 4; ++m)
#pragma unroll
                    for (int bj = 0; bj < 2; ++bj)
#pragma unroll
                        for (int n = 0; n < 2; ++n) *(f32x4*)(op0 + (size_t)(ai * 128 + m * 16) * D + bj * 128 + n * 16) = acc[ai][bj][m][n];
        } else if constexpr (MODE == EP_RESID) {
            const int col0 = u.pn * 256 + wc * 32 + 4 * fq;
#pragma unroll
            for (int ai = 0; ai < 2; ++ai)
#pragma unroll
                for (int m = 0; m < 4; ++m) { const int row = row0 + ai * 128 + m * 16;
                    const float* bp = row < MP ? baseP + (size_t)row * D : baseS + (size_t)(row - MP) * D; float* op = out + (size_t)row * D;
#pragma unroll
                    for (int bj = 0; bj < 2; ++bj)
#pragma unroll
                        for (int n = 0; n < 2; ++n) { const int c = col0 + bj * 128 + n * 16; const f32x4 b = *(const f32x4*)(bp + c); if (!dry) *(f32x4*)(op + c) = b + acc[ai][bj][m][n]; } }
        } else if constexpr (MODE == EP_SWIGLU) {
            const int col = u.pn * 128 + wc * 32 + 8 * fq;
#pragma unroll
            for (int ai = 0; ai < 2; ++ai)
#pragma unroll
                for (int m = 0; m < 4; ++m) { const int row = row0 + ai * 128 + m * 16; float o[8];
#pragma unroll
                    for (int n = 0; n < 2; ++n)
#pragma unroll
                        for (int e = 0; e < 4; ++e) o[4 * n + e] = siluf(acc[ai][0][m][n][e]) * acc[ai][1][m][n][e];
                    *(u32x4*)(O + (size_t)row * ldo + col) = pack8(o); }
        } else if constexpr (MODE == EP_RW1) {
            const int cw0 = wc * 32 + 8 * fq;
            if (u.pn < 12) { bf16_t* dst = O + (size_t)(u.pn >> 2) * ((WS_K - WS_R) / 2) + (u.pn & 3) * 256 + cw0;
#pragma unroll
                for (int ai = 0; ai < 2; ++ai)
#pragma unroll
                    for (int m = 0; m < 4; ++m)
#pragma unroll
                        for (int bj = 0; bj < 2; ++bj) { u32x4 pk; pk.x = pk2(acc[ai][bj][m][0][0], acc[ai][bj][m][0][1]); pk.y = pk2(acc[ai][bj][m][0][2], acc[ai][bj][m][0][3]);
                            pk.z = pk2(acc[ai][bj][m][1][0], acc[ai][bj][m][1][1]); pk.w = pk2(acc[ai][bj][m][1][2], acc[ai][bj][m][1][3]);
                            *(u32x4*)(dst + (size_t)(row0 + ai * 128 + m * 16) * D + bj * 128) = pk; }
            } else if (u.pn == 12) { const bool th = cw0 < 64;
#pragma unroll
                for (int ai = 0; ai < 2; ++ai)
#pragma unroll
                    for (int m = 0; m < 4; ++m) { float o[8];
#pragma unroll
                        for (int n = 0; n < 2; ++n)
#pragma unroll
                            for (int e = 0; e < 4; ++e) { const float v = acc[ai][0][m][n][e]; o[4 * n + e] = th ? tanh_f(v) : v; }
                        *(u32x4*)(O4 + (size_t)(row0 + ai * 128 + m * 16) * 128 + cw0) = pack8(o); }
            } else {
#pragma unroll
                for (int ai = 0; ai < 2; ++ai)
#pragma unroll
                    for (int m = 0; m < 4; ++m)
#pragma unroll
                        for (int bj = 0; bj < 2; ++bj) { float o[8];
#pragma unroll
                            for (int n = 0; n < 2; ++n)
#pragma unroll
                                for (int e = 0; e < 4; ++e) o[4 * n + e] = sigm(acc[ai][bj][m][n][e]);
                            *(u32x4*)(O5 + (size_t)(row0 + ai * 128 + m * 16) * 256 + bj * 128 + cw0) = pack8(o); }
            }
        } else if constexpr (MODE == EP_RW2) {
            const int c0 = (u.pn & 3) * 256 + wc * 32 + 8 * fq; const bool isw = u.pn < 4; const float* bias = isw ? v0 : v1; bf16_t* dst = O + (isw ? (size_t)0 : (WS_AA - WS_LD) / 2);
#pragma unroll
            for (int bj = 0; bj < 2; ++bj) { const f32x4 b0 = *(const f32x4*)(bias + c0 + bj * 128), b1 = *(const f32x4*)(bias + c0 + bj * 128 + 4);
                if (isw) {
#pragma unroll
                    for (int ai = 0; ai < 2; ++ai)
#pragma unroll
                        for (int m = 0; m < 4; ++m) { float o[8];
#pragma unroll
                            for (int e = 0; e < 4; ++e) { o[e] = -0.6065306597f * sigm(b0[e] + acc[ai][bj][m][0][e]); o[4 + e] = -0.6065306597f * sigm(b1[e] + acc[ai][bj][m][1][e]); }
                            *(u32x4*)(dst + (size_t)(row0 + ai * 128 + m * 16) * D + c0 + bj * 128) = pack8(o); asm volatile("" ::: "memory"); }
                } else {
#pragma unroll
                    for (int ai = 0; ai < 2; ++ai)
#pragma unroll
                        for (int m = 0; m < 4; ++m) { float o[8];
#pragma unroll
                            for (int e = 0; e < 4; ++e) { o[e] = sigm(b0[e] + acc[ai][bj][m][0][e]); o[4 + e] = sigm(b1[e] + acc[ai][bj][m][1][e]); }
                            *(u32x4*)(dst + (size_t)(row0 + ai * 128 + m * 16) * D + c0 + bj * 128) = pack8(o); asm volatile("" ::: "memory"); }
                } }
        } else {
#pragma unroll
            for (int ai = 0; ai < 2; ++ai)
#pragma unroll
                for (int m = 0; m < 4; ++m) { const int row = row0 + ai * 128 + m * 16;
#pragma unroll
                    for (int bj = 0; bj < 2; ++bj) { const int cw = bj * 128 + wc * 32 + 8 * fq; const int col = u.pn * 256 + cw; float o[8];
#pragma unroll
                        for (int n = 0; n < 2; ++n)
#pragma unroll
                            for (int e = 0; e < 4; ++e) o[4 * n + e] = acc[ai][bj][m][n][e];
                        if constexpr (MODE == EP_BF16) { *(u32x4*)(O + (size_t)row * ldo + col) = pack8(o); }
                        else if constexpr (MODE == EP_GLU) { float y[8]; unpack8(*(const u32x4*)(X + (size_t)row * ldx + col), y);
#pragma unroll
                            for (int e = 0; e < 8; ++e) o[e] = y[e] * sigm(o[e]);
                            *(u32x4*)(O + (size_t)row * ldo + col) = pack8(o); }
                        else if constexpr (MODE == EP_GATE) { bf16_t* p = O + (size_t)row * ldo + col; float y[8]; unpack8(*(const u32x4*)p, y);
#pragma unroll
                            for (int e = 0; e < 8; ++e) o[e] *= y[e];
                            if (!dry) *(u32x4*)p = pack8(o); }
                    } }
        }
    }
};

struct Args { const float* in[47]; float* out; unsigned char* ws; };
struct Ctx {
    const float* const* in; float* out; unsigned char* ws; LAS unsigned char* lds;
    int tid, lane, wave, G, blk;
};
enum { I_XP = 0, I_XS, I_S5RE, I_S5IM, I_GDN, I_CONV, I_RWKV, I_SHIFT, I_NMIX, I_NFFN, I_NFIN, I_WG, I_WU, I_WD, I_WIN, I_WOUT, I_LRE, I_LIM, I_LSTEP, I_BRE, I_BIM, I_CRE, I_CIM,
       I_S5D, I_WGLU, I_CONVW, I_ALOG, I_DTB, I_GNW, I_MAA, I_WR, I_WK, I_WV, I_WO, I_W0, I_W1, I_W2, I_A0, I_A1, I_A2, I_G1, I_G2, I_KK, I_KA, I_RK, I_LNW, I_LNB };

struct TJ { int in_idx, in_off, K, N; unsigned dst_off; int ldt, kofs, row_off, ilv, ksmode, ks_row, nitems; };
constexpr TJ mk_tj(int in_idx, int in_off, int K, int N, size_t dst, int ldt, int kofs, int row_off, int ilv, int ksmode, int ks_row) {
    return TJ{in_idx, in_off, K, N, (unsigned)dst, ldt, kofs, row_off, ilv, ksmode, ks_row, ((N + 31) / 32) * ((K + 63) / 64)}; }
constexpr int NTJ = 25;
__constant__ TJ g_tj[NTJ] = {
    mk_tj(14, 0, 1024, 2568, WS_W_IN, 1024, 0, 0, 0, 0, 0), mk_tj(24, 0, 512, 512, WS_W_GLU, 512, 0, 0, 0, 0, 0), mk_tj(15, 0, 1024, 1024, WS_W_OUT, 1024, 0, 0, 0, 0, 0),
    mk_tj(11, 0, 1024, 2816, WS_W_GU0, 1024, 0, 0, 1, 0, 0), mk_tj(12, 0, 1024, 2816, WS_W_GU0, 1024, 0, 128, 1, 0, 0), mk_tj(13, 0, 2816, 1024, WS_W_DN0, 2816, 0, 0, 0, 0, 0),
    mk_tj(11, 1024 * 2816, 1024, 2816, WS_W_GU1, 1024, 0, 0, 1, 0, 0), mk_tj(12, 1024 * 2816, 1024, 2816, WS_W_GU1, 1024, 0, 128, 1, 0, 0), mk_tj(13, 2816 * 1024, 2816, 1024, WS_W_DN1, 2816, 0, 0, 0, 0, 0),
    mk_tj(30, 0, 1024, 1024, WS_W_RW1, 2048, 0, 0, 0, 1, 0), mk_tj(31, 0, 1024, 1024, WS_W_RW1, 2048, 0, 1024, 0, 1, 2), mk_tj(32, 0, 1024, 1024, WS_W_RW1, 2048, 0, 2048, 0, 1, 3),
    mk_tj(35, 0, 1024, 64, WS_W_RW1, 2048, 0, 3072, 0, 1, 1), mk_tj(38, 0, 1024, 64, WS_W_RW1, 2048, 0, 3136, 0, 1, 4), mk_tj(40, 0, 1024, 160, WS_W_RW1, 2048, 0, 3328, 0, 1, 5),
    mk_tj(30, 0, 1024, 1024, WS_W_RW1, 2048, 1024, 0, 0, 2, 0), mk_tj(31, 0, 1024, 1024, WS_W_RW1, 2048, 1024, 1024, 0, 2, 2), mk_tj(32, 0, 1024, 1024, WS_W_RW1, 2048, 1024, 2048, 0, 2, 3),
    mk_tj(35, 0, 1024, 64, WS_W_RW1, 2048, 1024, 3072, 0, 2, 1), mk_tj(38, 0, 1024, 64, WS_W_RW1, 2048, 1024, 3136, 0, 2, 4), mk_tj(40, 0, 1024, 160, WS_W_RW1, 2048, 1024, 3328, 0, 2, 5),
    mk_tj(36, 0, 64, 1024, WS_W_RW2, 128, 0, 0, 0, 0, 0), mk_tj(39, 0, 64, 1024, WS_W_RW2, 128, 64, 1024, 0, 0, 0), mk_tj(41, 0, 160, 1024, WS_W_G2, 256, 0, 0, 0, 0, 0),
    mk_tj(33, 0, 1024, 1024, WS_W_O, 1024, 0, 0, 0, 0, 0) };
DI void tr_all(const Ctx& C, int j0, int j1, int b0) {
    LAS float* scr = (LAS float*)(C.lds + C.wave * 16384);
    const int lane = opaque_tid() & 63, gw = (C.blk - b0) * 8 + C.wave, NGW = (C.G - b0) * 8;
    int total = 0;
    for (int j = j0; j < j1; ++j) total += g_tj[j].nitems;
    for (int it0 = gw; it0 < total; it0 += NGW) {
        int it = __builtin_amdgcn_readfirstlane(it0), j = j0;
        while (it >= g_tj[j].nitems) { it -= g_tj[j].nitems; ++j; }
        const TJ J = g_tj[j];
        const float* W = C.in[J.in_idx] + J.in_off; const float* ks = C.in[I_MAA] + J.ks_row * 1024; bf16_t* WT = (bf16_t*)(C.ws + J.dst_off);
        const int K = J.K, N = J.N, nblk = (N + 31) / 32;
        const int kb = it / nblk, nb = it - kb * nblk, k0 = 64 * kb, n0 = 32 * nb;
        const int nn = n0 + (lane & 31); float v[32];
#pragma unroll
        for (int i = 0; i < 32; ++i) { const int k = k0 + 2 * i + (lane >> 5); v[i] = (k < K && nn < N) ? W[(size_t)k * N + nn] : 0.f; }
        if (J.ksmode) {
#pragma unroll
            for (int i = 0; i < 32; ++i) { const int k = k0 + 2 * i + (lane >> 5); const float s = (k < K) ? ks[k] : 0.f; v[i] *= (J.ksmode == 1) ? (1.f - s) : s; } }
#pragma unroll
        for (int i = 0; i < 32; ++i) scr[(2 * i + (lane >> 5)) * 33 + (lane & 31)] = v[i];
        LDS_WAIT();
        const int c = lane & 7;
#pragma unroll
        for (int jj = 0; jj < 4; ++jj) { const int n = (lane >> 3) + 8 * jj; const LAS float* s = scr + (8 * c) * 33 + n;
            u32x4 o; o.x = pk2(s[0 * 33], s[1 * 33]); o.y = pk2(s[2 * 33], s[3 * 33]); o.z = pk2(s[4 * 33], s[5 * 33]); o.w = pk2(s[6 * 33], s[7 * 33]);
            const int ng = n0 + n;
            if (ng < N) { const int dr = J.row_off + (J.ilv ? ((ng >> 7) * 256 + (ng & 127)) : ng); *(u32x4*)(WT + (size_t)dr * J.ldt + J.kofs + k0 + 8 * c) = o; } }
        LDS_WAIT();
    }
}
DI void zero_rect(const Ctx& C, bf16_t* P, int ld, int row0, int nrows, int col0, int ncols, int b0 = 0) {
    const int cpr = ncols / 8, total = nrows * cpr;
    for (int e = (C.blk - b0) * 512 + opaque_tid(); e < total; e += (C.G - b0) * 512) { const int r = e / cpr, c = e % cpr; *(u32x4*)(P + (size_t)(row0 + r) * ld + col0 + 8 * c) = (u32x4){0u, 0u, 0u, 0u}; }
}

template <int MODE> DI void rms_rows(const Ctx& C, const float* srcP, const float* srcS, const float* w, bf16_t* dst, const float* part = nullptr, int nslice = 0, const float* baseS = nullptr) {
    const int gw = C.blk * 8 + C.wave, NGW = C.G * 8, lane = opaque_tid() & 63;
    f32x4 wv[4];
#pragma unroll
    for (int j = 0; j < 4; ++j) wv[j] = *(const f32x4*)(w + 4 * lane + 256 * j);
    for (int m = gw; m < M; m += NGW) {
        const float* xr = m < MP ? srcP + (size_t)m * D : srcS + (size_t)(m - MP) * D;
        f32x4 v[4]; float s = 0.f;
#pragma unroll
        for (int j = 0; j < 4; ++j) v[j] = *(const f32x4*)(xr + 4 * lane + 256 * j);
        if (part && m >= MP) { const float* bs = baseS + (size_t)(m - MP) * D;
#pragma unroll
            for (int j = 0; j < 4; ++j) v[j] = *(const f32x4*)(bs + 4 * lane + 256 * j);
            for (int sl = 0; sl < nslice; ++sl) { const float* pp = part + ((size_t)sl * MS + (size_t)(m - MP)) * D;
#pragma unroll
                for (int j = 0; j < 4; ++j) v[j] += *(const f32x4*)(pp + 4 * lane + 256 * j); }
            if constexpr (MODE != 2) { float* xw = const_cast<float*>(xr);
#pragma unroll
                for (int j = 0; j < 4; ++j) *(f32x4*)(xw + 4 * lane + 256 * j) = v[j]; } }
#pragma unroll
        for (int j = 0; j < 4; ++j) s += (v[j].x * v[j].x + v[j].y * v[j].y) + (v[j].z * v[j].z + v[j].w * v[j].w);
        const float rstd = __builtin_amdgcn_rsqf(wave_sum(s) * (1.f / D) + NORM_EPS);
#pragma unroll
        for (int j = 0; j < 4; ++j) v[j] = v[j] * rstd * wv[j];
        if constexpr (MODE == 2) {
            float* o = C.out + (size_t)m * D;
#pragma unroll
            for (int j = 0; j < 4; ++j) *(f32x4*)(o + 4 * lane + 256 * j) = v[j];
        } else {
            u32x2 pk[4];
#pragma unroll
            for (int j = 0; j < 4; ++j) { pk[j].x = pk2(v[j].x, v[j].y); pk[j].y = pk2(v[j].z, v[j].w); }
            if constexpr (MODE == 0) {
#pragma unroll
                for (int j = 0; j < 4; ++j) *(u32x2*)(dst + (size_t)m * D + 4 * lane + 256 * j) = pk[j];
            } else {
                const bool prompt = m < MP; const int pos = prompt ? (m & (SEQP - 1)) : ((m - MP) & (SEQS - 1)); const int len = prompt ? SEQP : SEQS;
                const int b = prompt ? (m >> 11) : ((m - MP) >> 3);
#pragma unroll
                for (int j = 0; j < 4; ++j) *(u32x2*)(dst + (size_t)m * 2048 + 4 * lane + 256 * j) = pk[j];
                if (pos + 1 < len) {
#pragma unroll
                    for (int j = 0; j < 4; ++j) *(u32x2*)(dst + (size_t)(m + 1) * 2048 + 1024 + 4 * lane + 256 * j) = pk[j];
                } else {
                    float* so = C.out + (prompt ? O_P_SHIFT : O_S_SHIFT) + (size_t)b * D;
#pragma unroll
                    for (int j = 0; j < 4; ++j) *(f32x4*)(so + 4 * lane + 256 * j) = v[j];
                }
                if (pos == 0) {
#pragma unroll
                    for (int j = 0; j < 4; ++j) { u32x2 z = {0u, 0u};
                        if (!prompt) { const f32x4 sv = *(const f32x4*)(C.in[I_SHIFT] + (size_t)b * D + 4 * lane + 256 * j); z.x = pk2(sv.x, sv.y); z.y = pk2(sv.z, sv.w); }
                        *(u32x2*)(dst + (size_t)m * 2048 + 1024 + 4 * lane + 256 * j) = z; }
                }
            }
        }
    }
}

constexpr size_t WS_S5E = 0, WS_YG = 239 * MiB;
constexpr int S5SEG = 256;
static_assert(WS_YG + (size_t)M * 512 * 2 <= WS_END && 222 * MiB + (size_t)M * 512 * 2 <= WS_YG, "yg");
template <int MODE> DI void s5_unit(const Ctx& C, int seq, int g, int seg) {
    const int lane = opaque_tid() & 63, p = lane, r = lane & 15, q = lane >> 4;
    LAS unsigned char* wl = C.lds + C.wave * 16384;
    const bool prompt = seq < NBP; const int b = prompt ? seq : seq - NBP; const int start = prompt ? seq * SEQP + seg * S5SEG : MP + b * SEQS; const int len = prompt ? S5SEG : SEQS;
    const bf16_t* PROJ = (const bf16_t*)(C.ws + WS_PROJ); bf16_t* YG = (bf16_t*)(C.ws + WS_YG);
    float* E = (float*)(C.ws + WS_S5E);
    float abr, abi;
    bf16x8 Bf[8], Cf[4]; float dsk[4];
    {
        const float lr = C.in[I_LRE][g * 64 + p], li = C.in[I_LIM][g * 64 + p], dt = expf(C.in[I_LSTEP][g]);
        const float mag = expf(lr * dt); abr = mag * cosf(li * dt); abi = mag * sinf(li * dt);
        const float den = lr * lr + li * li, nr = abr - 1.f, ni = abi, cr = (nr * lr + ni * li) / den, ci = (ni * lr - nr * li) / den;
        LAS bf16_t* BB = (LAS bf16_t*)wl;
        const float* bre = C.in[I_BRE] + (size_t)(g * 64 + p) * 16; const float* bim = C.in[I_BIM] + (size_t)(g * 64 + p) * 16;
#pragma unroll
        for (int c = 0; c < 16; c += 2) { const float r0 = bre[c], i0 = bim[c], r1 = bre[c + 1], i1 = bim[c + 1];
            *(LAS unsigned*)(BB + p * 16 + c) = pk2(cr * r0 - ci * i0, cr * r1 - ci * i1);
            *(LAS unsigned*)(BB + (64 + p) * 16 + c) = pk2(cr * i0 + ci * r0, cr * i1 + ci * r1); }
        LDS_WAIT();
#pragma unroll
        for (int nb = 0; nb < 8; ++nb) { bf16x8 z = {0, 0, 0, 0, 0, 0, 0, 0}; if (q < 2) z = *(const LAS bf16x8*)(BB + (16 * nb + r) * 16 + 8 * q); Bf[nb] = z; }
        LDS_WAIT();
        if constexpr (MODE == 2) {
#pragma unroll
            for (int kk = 0; kk < 4; ++kk) { const float* src = (kk < 2 ? C.in[I_CRE] : C.in[I_CIM]) + (size_t)(g * 16 + r) * 64 + 32 * (kk & 1) + 8 * q; const float sg = kk < 2 ? 1.f : -1.f;
                float x[8];
#pragma unroll
                for (int e = 0; e < 8; ++e) x[e] = sg * src[e];
                Cf[kk] = __builtin_bit_cast(bf16x8, pack8(x)); }
#pragma unroll
            for (int i = 0; i < 4; ++i) dsk[i] = C.in[I_S5D][g * 16 + 4 * q + i];
        }
    }
    float xr = 0.f, xi = 0.f;
    if constexpr (MODE == 2) {
        if (!prompt) { xr = C.in[I_S5RE][(size_t)(b * 32 + g) * 64 + p]; xi = C.in[I_S5IM][(size_t)(b * 32 + g) * 64 + p]; }
        else if (seg > 0) {
            float pr = abr, pi = abi;
#pragma unroll
            for (int i = 0; i < 8; ++i) { const float nr2 = pr * pr - pi * pi, ni2 = 2.f * pr * pi; pr = nr2; pi = ni2; }
            const float* e0 = E + ((size_t)(seq * 32 + g) * 8) * 128 + p;
            for (int s = 0; s < seg; ++s) { const float er = e0[s * 128], ei = e0[s * 128 + 64]; const float nxr = pr * xr - pi * xi + er, nxi = pr * xi + pi * xr + ei; xr = nxr; xi = nxi; }
        }
    }
    LAS float* XT = (LAS float*)wl;
    bf16x8 UfN = {0, 0, 0, 0, 0, 0, 0, 0}; u32x2 udN = {0u, 0u};
    { int mr = start + r; if (mr > M - 1) mr = M - 1;
      if (q < 2) UfN = *(const bf16x8*)(PROJ + (size_t)mr * NPROJ + 16 * g + 8 * q);
      if constexpr (MODE == 2) udN = *(const u32x2*)(PROJ + (size_t)mr * NPROJ + 16 * g + 4 * q); }
    for (int t0 = 0; t0 < len; t0 += 16) {
        const int nt = (len - t0) < 16 ? (len - t0) : 16; const int m0 = start + t0;
        const bf16x8 Uf = UfN; const u32x2 ud = udN;
        if (t0 + 16 < len) { int mr = m0 + 16 + r; if (mr > M - 1) mr = M - 1;
            if (q < 2) UfN = *(const bf16x8*)(PROJ + (size_t)mr * NPROJ + 16 * g + 8 * q);
            if constexpr (MODE == 2) udN = *(const u32x2*)(PROJ + (size_t)mr * NPROJ + 16 * g + 4 * q); }
#pragma unroll
        for (int nb = 0; nb < 8; ++nb) { f32x4 a = {0.f, 0.f, 0.f, 0.f}; a = MFMA16(Bf[nb], Uf, a); *(LAS f32x4*)(XT + r * 132 + 16 * nb + 4 * q) = a; }
        LDS_WAIT();
        for (int tl = 0; tl < nt; ++tl) {
            const float bur = XT[tl * 132 + p], bui = XT[tl * 132 + 64 + p];
            const float nxr = abr * xr - abi * xi + bur, nxi = abr * xi + abi * xr + bui;
            xr = nxr; xi = nxi;
            if constexpr (MODE == 2) { XT[tl * 132 + p] = xr; XT[tl * 132 + 64 + p] = xi; }
        }
        LDS_WAIT();
        if constexpr (MODE == 2) {
            f32x4 y = {0.f, 0.f, 0.f, 0.f};
#pragma unroll
            for (int kk = 0; kk < 4; ++kk) { const f32x4 a0 = *(const LAS f32x4*)(XT + r * 132 + 32 * kk + 8 * q), a1 = *(const LAS f32x4*)(XT + r * 132 + 32 * kk + 8 * q + 4);
                u32x4 w; w.x = pk2(a0.x, a0.y); w.y = pk2(a0.z, a0.w); w.z = pk2(a1.x, a1.y); w.w = pk2(a1.z, a1.w);
                y = MFMA16(Cf[kk], __builtin_bit_cast(bf16x8, w), y); }
            const float u0 = bf_lo(ud.x), u1 = bf_hi(ud.x), u2 = bf_lo(ud.y), u3 = bf_hi(ud.y);
            const float g0 = gelu_t(y[0] + dsk[0] * u0), g1 = gelu_t(y[1] + dsk[1] * u1), g2 = gelu_t(y[2] + dsk[2] * u2), g3 = gelu_t(y[3] + dsk[3] * u3);
            if (r < nt) { u32x2 o; o.x = pk2(g0, g1); o.y = pk2(g2, g3); *(u32x2*)(YG + (size_t)(m0 + r) * 512 + 16 * g + 4 * q) = o; }
            LDS_WAIT();
        }
    }
    if constexpr (MODE == 1) { float* e0 = E + ((size_t)(seq * 32 + g) * 8 + seg) * 128 + p; e0[0] = xr; e0[64] = xi; }
    else if (!prompt || seg == 7) {
        float* ore = C.out + (prompt ? O_P_S5RE : O_S_S5RE) + (size_t)(b * 32 + g) * 64 + p; float* oim = C.out + (prompt ? O_P_S5IM : O_S_S5IM) + (size_t)(b * 32 + g) * 64 + p;
        *ore = xr; *oim = xi; }
}

constexpr size_t GDN_FR_BYTES = 57344 + 256;
constexpr size_t WS_UG = WS_HB;
constexpr size_t WS_OB = 222 * MiB;
static_assert(WS_OB + (size_t)M * 512 * 2 <= WS_END && (size_t)1024 * 32768 <= 34 * MiB && (size_t)1024 * GDN_FR_BYTES <= (size_t)M * D * 4, "gdn scratch");

DI void gdn_state_step(LAS unsigned char* fb, f32x4 (&Sacc)[8], const f32x4 (&Uacc)[4], bf16_t* OBrow  , int ntok, int lane, int w) {
    const int r = lane & 15, q = lane >> 4;
    const LAS float* gcV = (const LAS float*)(fb + 57344);
#define FRAG(f) (*(const LAS bf16x8*)(fb + (f) * 1024 + lane * 16))
    bf16x8 Sf[4];
#pragma unroll
    for (int kk = 0; kk < 4; ++kk) { u32x4 p; p.x = pk2(Sacc[2 * kk][0], Sacc[2 * kk][1]); p.y = pk2(Sacc[2 * kk][2], Sacc[2 * kk][3]); p.z = pk2(Sacc[2 * kk + 1][0], Sacc[2 * kk + 1][1]); p.w = pk2(Sacc[2 * kk + 1][2], Sacc[2 * kk + 1][3]);
        Sf[kk] = __builtin_bit_cast(bf16x8, p); }
    const float glast = gcV[63];
    f32x4 vn[4], oacc[4];
#pragma unroll
    for (int tb = 0; tb < 4; ++tb) { f32x4 ws = {0.f, 0.f, 0.f, 0.f}, qs = {0.f, 0.f, 0.f, 0.f};
#pragma unroll
        for (int kk = 0; kk < 4; ++kk) { ws = MFMA16(FRAG(tb * 4 + kk), Sf[kk], ws); qs = MFMA16(FRAG(16 + tb * 4 + kk), Sf[kk], qs); }
        vn[tb] = Uacc[tb] - ws;
        const f32x4 g4 = *(const LAS f32x4*)(gcV + 16 * tb + 4 * q);
#pragma unroll
        for (int i = 0; i < 4; ++i) qs[i] *= __expf(g4[i]);
        oacc[tb] = qs; }
    bf16x8 Vf[2], Vsf[2];
#pragma unroll
    for (int k2 = 0; k2 < 2; ++k2) { u32x4 p, ps; const f32x4 g0 = *(const LAS f32x4*)(gcV + 32 * k2 + 4 * q), g1 = *(const LAS f32x4*)(gcV + 32 * k2 + 16 + 4 * q); float sc0[4], sc1[4];
#pragma unroll
        for (int i = 0; i < 4; ++i) { sc0[i] = __expf(glast - g0[i]); sc1[i] = __expf(glast - g1[i]); }
        const f32x4 v0 = vn[2 * k2], v1 = vn[2 * k2 + 1];
        p.x = pk2(v0[0], v0[1]); p.y = pk2(v0[2], v0[3]); p.z = pk2(v1[0], v1[1]); p.w = pk2(v1[2], v1[3]);
        ps.x = pk2(v0[0] * sc0[0], v0[1] * sc0[1]); ps.y = pk2(v0[2] * sc0[2], v0[3] * sc0[3]); ps.z = pk2(v1[0] * sc1[0], v1[1] * sc1[1]); ps.w = pk2(v1[2] * sc1[2], v1[3] * sc1[3]);
        Vf[k2] = __builtin_bit_cast(bf16x8, p); Vsf[k2] = __builtin_bit_cast(bf16x8, ps); }
#pragma unroll
    for (int tb = 0; tb < 4; ++tb)
#pragma unroll
        for (int k2 = 0; k2 < 2; ++k2) oacc[tb] = MFMA16(FRAG(32 + tb * 2 + k2), Vf[k2], oacc[tb]);
    { const float eg = __expf(glast);
#pragma unroll
      for (int kb = 0; kb < 8; ++kb) { f32x4 s = Sacc[kb] * eg;
#pragma unroll
        for (int k2 = 0; k2 < 2; ++k2) s = MFMA16(FRAG(40 + kb * 2 + k2), Vsf[k2], s);
        Sacc[kb] = s; } }
#undef FRAG
#pragma unroll
    for (int tb = 0; tb < 4; ++tb)
#pragma unroll
        for (int i = 0; i < 4; ++i) { const int t = 16 * tb + 4 * q + i; if (t < ntok) OBrow[(size_t)t * 512 + 16 * w + r] = f2bf(oacc[tb][i]); }
}

DI void gdn_unit(const Ctx& C, int seq, int t0, int h) {
    const int tid = opaque_tid(), lane = tid & 63, w = C.wave, r = lane & 15, q = lane >> 4;
    const bool prompt = seq < NBP; const int b = prompt ? seq : seq - NBP; const int start = prompt ? seq * SEQP : MP + b * SEQS; const int len = prompt ? SEQP : SEQS;
    const bf16_t* PROJ = (const bf16_t*)(C.ws + WS_PROJ);
    LAS unsigned char* L = C.lds;
    LAS bf16_t* Kn = (LAS bf16_t*)(L + 0);
    LAS bf16_t* Qn = (LAS bf16_t*)(L + 17408);
    LAS bf16_t* Knt = (LAS bf16_t*)(L + 34816);
    LAS bf16_t* Vt = (LAS bf16_t*)(L + 53248);
    LAS float* Lm = (LAS float*)(L + 71680);
    LAS bf16_t* Wl = (LAS bf16_t*)(L + 71680);
    LAS float* Tm = (LAS float*)(L + 89088);
    LAS bf16_t* Tp = (LAS bf16_t*)(L + 105728);
    LAS bf16_t* Tpp = (LAS bf16_t*)(L + 114944);
    LAS bf16_t* Aqk = (LAS bf16_t*)(L + 124160);
    LAS float* Pb = (LAS float*)(L + 133376);
    LAS float* betaV = (LAS float*)(L + 136640);
    LAS float* gcV = betaV + 64;
    const int ntok = (len - t0) < 64 ? (len - t0) : 64;
    if (tid < 384) {
        const int tg = tid / 48, combo = tid - 48 * tg, ty = combo >> 4, cgp = combo & 15; const int cc = ty * 512 + h * 128 + 8 * cgp;
        u32x4 raw[11]; float xs[3][8];
#pragma unroll
        for (int j = 0; j < 3; ++j)
#pragma unroll
            for (int e = 0; e < 8; ++e) xs[j][e] = 0.f;
#pragma unroll
        for (int j = 0; j < 11; ++j) { const int tt = t0 + 8 * tg - 3 + j; raw[j] = (u32x4){0u, 0u, 0u, 0u};
            if (tt >= 0 && tt < len) raw[j] = *(const u32x4*)(PROJ + (size_t)(start + tt) * NPROJ + 512 + cc); }
        const bool head = (t0 + 8 * tg) < 3;
        if (head && !prompt) {
#pragma unroll
            for (int j = 0; j < 3; ++j) { const float* cs = C.in[I_CONV] + (size_t)(b * 3 + j) * 1536 + cc;
#pragma unroll
                for (int e = 0; e < 8; ++e) xs[j][e] = cs[e]; } }
        f32x4 cw[4][2];
#pragma unroll
        for (int j = 0; j < 4; ++j) { cw[j][0] = *(const f32x4*)(C.in[I_CONVW] + (size_t)j * 1536 + cc); cw[j][1] = *(const f32x4*)(C.in[I_CONVW] + (size_t)j * 1536 + cc + 4); }
        float out[8][8];
#pragma unroll
        for (int s = 0; s < 8; ++s) { float a[8];
#pragma unroll
            for (int e = 0; e < 8; ++e) a[e] = 0.f;
#pragma unroll
            for (int j = 0; j < 4; ++j) { float xv[8]; unpack8(raw[s + j], xv);
                if (s + j < 3) { if (head) {
#pragma unroll
                        for (int e = 0; e < 8; ++e) xv[e] = xs[s + j][e]; } }
#pragma unroll
                for (int e = 0; e < 8; ++e) a[e] += xv[e] * cw[j][e >> 2][e & 3]; }
            const bool valid = (8 * tg + s) < ntok; float ss = 0.f;
#pragma unroll
            for (int e = 0; e < 8; ++e) { a[e] = valid ? siluf(a[e]) : 0.f; ss += a[e] * a[e]; }
            ss = sum16(ss);
            const float rs = (ty < 2) ? (__builtin_amdgcn_rsqf(ss + NORM_EPS)) * (ty == 0 ? 0.08838834764831845f : 1.f) : 1.f;
#pragma unroll
            for (int e = 0; e < 8; ++e) out[s][e] = a[e] * rs; }
        if (ty < 2) { LAS bf16_t* dst = (ty == 0 ? Qn : Kn) + (8 * tg) * 136 + 8 * cgp;
#pragma unroll
            for (int s = 0; s < 8; ++s) *(LAS u32x4*)(dst + s * 136) = pack8(out[s]); }
        if (ty >= 1) { LAS bf16_t* dst = (ty == 1 ? Knt : Vt) + (8 * cgp) * 72 + 8 * tg;
#pragma unroll
            for (int e = 0; e < 8; ++e) { u32x4 pk; pk.x = pk2(out[0][e], out[1][e]); pk.y = pk2(out[2][e], out[3][e]); pk.z = pk2(out[4][e], out[5][e]); pk.w = pk2(out[6][e], out[7][e]);
                *(LAS u32x4*)(dst + e * 72) = pk; } }
    } else if (w == 6) { const int t = lane; float bt = 0.f, gg = 0.f;
        if (t < ntok) { const size_t mrow = (size_t)(start + t0 + t) * NPROJ; bt = sigm(bf1(PROJ[mrow + 2048 + h])); gg = -expf(C.in[I_ALOG][h]) * softplusf(bf1(PROJ[mrow + 2052 + h]) + C.in[I_DTB][h]); }
        float s = gg;
#pragma unroll
        for (int o = 1; o < 64; o <<= 1) { const float v = __shfl_up(s, o); if (lane >= o) s += v; }
        betaV[t] = bt; gcV[t] = s; }
    LBAR();
#pragma unroll 1
    for (int b4 = 0; b4 < 4; ++b4) { const int idx = 4 * w + b4; const bool isq = idx >= 16; const int id = idx & 15, bi = id >> 2, bj = id & 3;
        const LAS bf16_t* Asrc = isq ? Qn : Kn; f32x4 a = {0.f, 0.f, 0.f, 0.f};
#pragma unroll
        for (int kk = 0; kk < 4; ++kk) a = MFMA16(*(const LAS bf16x8*)(Asrc + (16 * bi + r) * 136 + 32 * kk + 8 * q), *(const LAS bf16x8*)(Kn + (16 * bj + r) * 136 + 32 * kk + 8 * q), a);
        const int j = 16 * bj + r; const float gj = gcV[j];
#pragma unroll
        for (int ii = 0; ii < 4; ++ii) { const int i = 16 * bi + 4 * q + ii; const float e = (i >= j) ? __expf(gcV[i] - gj) : 0.f;
            if (!isq) Lm[i * 65 + j] = (i > j) ? betaV[i] * a[ii] * e : 0.f;
            else Aqk[i * 72 + j] = f2bf(a[ii] * e); } }
    LBAR();
    if (tid < 64) { const int bb = tid >> 4, c = tid & 15; float t[16];
#pragma unroll
        for (int i = 0; i < 16; ++i) { float s = (i == c) ? 1.f : 0.f;
#pragma unroll
            for (int j = 0; j < i; ++j) s -= Lm[(16 * bb + i) * 65 + 16 * bb + j] * t[j];
            t[i] = s; Tm[(16 * bb + i) * 65 + 16 * bb + c] = s; } }
    LBAR();
#pragma unroll 1
    for (int I = 1; I < 4; ++I) {
        for (int it = tid; it < I * 256; it += 512) { const int J = it >> 8, i = (it >> 4) & 15, j = it & 15; float s = 0.f;
            for (int Kb = J; Kb < I; ++Kb)
#pragma unroll
                for (int k = 0; k < 16; ++k) s += Lm[(16 * I + i) * 65 + 16 * Kb + k] * Tm[(16 * Kb + k) * 65 + 16 * J + j];
            Pb[(J * 16 + i) * 17 + j] = s; }
        LBAR();
        for (int it = tid; it < I * 256; it += 512) { const int J = it >> 8, i = (it >> 4) & 15, j = it & 15; float s = 0.f;
#pragma unroll
            for (int k = 0; k < 16; ++k) s += Tm[(16 * I + i) * 65 + 16 * I + k] * Pb[(J * 16 + k) * 17 + j];
            Tm[(16 * I + i) * 65 + 16 * J + j] = -s; }
        LBAR();
    }
    for (int e = tid; e < 4096; e += 512) { const int i = e >> 6, j = e & 63; const float tv = (j <= i) ? Tm[i * 65 + j] : 0.f; const float bj = betaV[j];
        Tp[i * 72 + j] = f2bf(tv * bj * __expf(gcV[j])); Tpp[i * 72 + j] = f2bf(tv * bj); }
    LBAR();
    f32x4 Uacc[4];
#pragma unroll
    for (int tb = 0; tb < 4; ++tb) { f32x4 a = {0.f, 0.f, 0.f, 0.f}, u = {0.f, 0.f, 0.f, 0.f};
#pragma unroll
        for (int kk = 0; kk < 2; ++kk) {
            a = MFMA16(*(const LAS bf16x8*)(Knt + (16 * w + r) * 72 + 32 * kk + 8 * q), *(const LAS bf16x8*)(Tp + (16 * tb + r) * 72 + 32 * kk + 8 * q), a);
            u = MFMA16(*(const LAS bf16x8*)(Tpp + (16 * tb + r) * 72 + 32 * kk + 8 * q), *(const LAS bf16x8*)(Vt + (16 * w + r) * 72 + 32 * kk + 8 * q), u); }
        u32x2 o; o.x = pk2(a[0], a[1]); o.y = pk2(a[2], a[3]); *(LAS u32x2*)(Wl + (16 * tb + r) * 136 + 16 * w + 4 * q) = o;
        Uacc[tb] = u; }
    LBAR();
    u32x4 fr[7];
#pragma unroll
    for (int i = 0; i < 7; ++i) { const int f = 7 * w + i; const LAS bf16_t* src; int rowb, ld, cb;
        if (f < 16) { src = Wl; ld = 136; rowb = 16 * (f >> 2); cb = 32 * (f & 3); }
        else if (f < 32) { src = Qn; ld = 136; rowb = 16 * ((f - 16) >> 2); cb = 32 * (f & 3); }
        else if (f < 40) { src = Aqk; ld = 72; rowb = 16 * ((f - 32) >> 1); cb = 32 * (f & 1); }
        else { src = Knt; ld = 72; rowb = 16 * ((f - 40) >> 1); cb = 32 * (f & 1); }
        const u32x2 a0 = *(const LAS u32x2*)(src + (rowb + r) * ld + cb + 4 * q), a1 = *(const LAS u32x2*)(src + (rowb + r) * ld + cb + 16 + 4 * q);
        fr[i] = (u32x4){a0.x, a0.y, a1.x, a1.y}; }
    const float gcl = (tid < 64) ? gcV[tid] : 0.f;
    if (prompt) {
        const int u = (seq * 32 + (t0 >> 6)) * 4 + h;
        unsigned char* frg = (unsigned char*)C.out + (size_t)u * GDN_FR_BYTES;
#pragma unroll
        for (int i = 0; i < 7; ++i) *(u32x4*)(frg + (size_t)(7 * w + i) * 1024 + lane * 16) = fr[i];
        if (tid < 64) *(float*)(frg + 57344 + tid * 4) = gcl;
        f32x4* ug = (f32x4*)(C.ws + WS_UG + (size_t)u * 32768) + (w * 4) * 64 + lane;
#pragma unroll
        for (int tb = 0; tb < 4; ++tb) ug[tb * 64] = Uacc[tb];
        LBAR();
    } else {
        LBAR();
#pragma unroll
        for (int i = 0; i < 7; ++i) *(LAS u32x4*)(L + (7 * w + i) * 1024 + lane * 16) = fr[i];
        if (tid < 64) *(LAS float*)(L + 57344 + tid * 4) = gcl;
        f32x4 Sacc[8];
        { const float* s0 = C.in[I_GDN] + (size_t)(b * 4 + h) * 16384 + (4 * q) * 128 + 16 * w + r;
#pragma unroll
          for (int kb = 0; kb < 8; ++kb)
#pragma unroll
            for (int i = 0; i < 4; ++i) Sacc[kb][i] = s0[(16 * kb + i) * 128]; }
        LBAR();
        gdn_state_step(L, Sacc, Uacc, (bf16_t*)(C.ws + WS_OB) + (size_t)(start + t0) * 512 + h * 128, ntok, lane, w);
        { int lo = (4 * q) * 128 + 16 * w + r; asm volatile("" : "+v"(lo));
          float* so = C.out + O_S_GDN + (size_t)(b * 4 + h) * 16384 + lo;
#pragma unroll
          for (int kb = 0; kb < 8; ++kb)
#pragma unroll
            for (int i = 0; i < 4; ++i) so[(16 * kb + i) * 128] = Sacc[kb][i]; }
        float* co = C.out + O_S_CONV + (size_t)b * 3 * 1536;
        for (int e = tid; e < 1152; e += 512) { const int j = e / 384, rem = e - 384 * j, ty = rem >> 7, d = rem & 127; const int cc = ty * 512 + h * 128 + d;
            co[j * 1536 + cc] = bf1(PROJ[(size_t)(start + len - 3 + j) * NPROJ + 512 + cc]); }
        LBAR();
    }
}

DI void gdn_seq(const Ctx& C, int seq, int h, int half) {
    const int tid = opaque_tid(), lane = tid & 63, w = 4 * half + (C.wave & 3), r = lane & 15, q = lane >> 4; const bool act = C.wave < 4;
    const int start = seq * SEQP; const bf16_t* PROJ = (const bf16_t*)(C.ws + WS_PROJ);
    LAS unsigned char* L = C.lds; constexpr int BUF = 58368;
    f32x4 Sacc[8];
#pragma unroll
    for (int kb = 0; kb < 8; ++kb) Sacc[kb] = (f32x4){0.f, 0.f, 0.f, 0.f};
    const int u0 = (seq * 32) * 4 + h;
    u32x4 pf[7]; u32x4 pg = {0u, 0u, 0u, 0u}; f32x4 Un[4], Uc[4];
    { const unsigned char* frg = (const unsigned char*)C.out + (size_t)u0 * GDN_FR_BYTES;
#pragma unroll
      for (int i = 0; i < 7; ++i) pf[i] = *(const u32x4*)(frg + (size_t)i * 8192 + tid * 16);
      if (tid < 16) pg = *(const u32x4*)(frg + 57344 + tid * 16);
      const f32x4* ug = (const f32x4*)(C.ws + WS_UG + (size_t)u0 * 32768) + (w * 4) * 64 + lane;
#pragma unroll
      for (int tb = 0; tb < 4; ++tb) Un[tb] = ug[tb * 64];
#pragma unroll
      for (int i = 0; i < 7; ++i) *(LAS u32x4*)(L + i * 8192 + tid * 16) = pf[i];
      if (tid < 16) *(LAS u32x4*)(L + 57344 + tid * 16) = pg; }
#pragma unroll 1
    for (int c = 0; c < 32; ++c) {
        LBAR();
        LAS unsigned char* fb = L + (c & 1) * BUF;
#pragma unroll
        for (int tb = 0; tb < 4; ++tb) Uc[tb] = Un[tb];
        if (c + 1 < 32) { const int u = u0 + (c + 1) * 4; const unsigned char* frg = (const unsigned char*)C.out + (size_t)u * GDN_FR_BYTES;
#pragma unroll
            for (int i = 0; i < 7; ++i) pf[i] = *(const u32x4*)(frg + (size_t)i * 8192 + tid * 16);
            if (tid < 16) pg = *(const u32x4*)(frg + 57344 + tid * 16);
            const f32x4* ug = (const f32x4*)(C.ws + WS_UG + (size_t)u * 32768) + (w * 4) * 64 + lane;
#pragma unroll
            for (int tb = 0; tb < 4; ++tb) Un[tb] = ug[tb * 64]; }
        if (act) gdn_state_step(fb, Sacc, Uc, (bf16_t*)(C.ws + WS_OB) + (size_t)(start + c * 64) * 512 + h * 128, 64, lane, w);
        if (c + 1 < 32) { LAS unsigned char* nb = L + ((c + 1) & 1) * BUF;
#pragma unroll
            for (int i = 0; i < 7; ++i) *(LAS u32x4*)(nb + i * 8192 + tid * 16) = pf[i];
            if (tid < 16) *(LAS u32x4*)(nb + 57344 + tid * 16) = pg; }
    }
    if (act) { int lo = (4 * q) * 128 + 16 * w + r; asm volatile("" : "+v"(lo));
      float* so = C.out + O_P_GDN + (size_t)(seq * 4 + h) * 16384 + lo;
#pragma unroll
      for (int kb = 0; kb < 8; ++kb)
#pragma unroll
        for (int i = 0; i < 4; ++i) so[(16 * kb + i) * 128] = Sacc[kb][i]; }
    float* co = C.out + O_P_CONV + (size_t)seq * 3 * 1536;
    if (half == 0) for (int e = tid; e < 1152; e += 512) { const int j = e / 384, rem = e - 384 * j, ty = rem >> 7, d = rem & 127; const int cc = ty * 512 + h * 128 + d;
        co[j * 1536 + cc] = bf1(PROJ[(size_t)(start + SEQP - 3 + j) * NPROJ + 512 + cc]); }
}

DI void gdn_post(const Ctx& C, int b0, int it0, int it1) {
    const int tid = opaque_tid(), l16 = tid & 15; const int grp = ((C.blk - b0) * 512 + tid) >> 4, ngrp = (C.G - b0) * 32;
    const bf16_t* OB = (const bf16_t*)(C.ws + WS_OB); const bf16_t* PROJ = (const bf16_t*)(C.ws + WS_PROJ); bf16_t* CAT = (bf16_t*)(C.ws + WS_CAT);
    const f32x4 n0 = *(const f32x4*)(C.in[I_GNW] + 8 * l16), n1 = *(const f32x4*)(C.in[I_GNW] + 8 * l16 + 4);
    for (int it = it0 + grp; it < it1; it += ngrp) { const int m = it >> 2, h = it & 3; float o[8], z[8];
        unpack8(*(const u32x4*)(OB + (size_t)m * 512 + h * 128 + 8 * l16), o); unpack8(*(const u32x4*)(PROJ + (size_t)m * NPROJ + 2056 + h * 128 + 8 * l16), z);
        float ss = 0.f;
#pragma unroll
        for (int e = 0; e < 8; ++e) ss += o[e] * o[e];
        ss = sum16(ss); const float rstd = __builtin_amdgcn_rsqf(ss * (1.f / 128.f) + NORM_EPS);
#pragma unroll
        for (int e = 0; e < 8; ++e) o[e] = o[e] * rstd * (e < 4 ? n0[e & 3] : n1[e & 3]) * siluf(z[e]);
        *(u32x4*)(CAT + (size_t)m * D + 512 + h * 128 + 8 * l16) = pack8(o); }
}

#ifndef RW_EXP
#define RW_EXP 0
#endif
#ifndef RW_SKIP
#define RW_SKIP 0
#endif
struct RwRaw { u32x2 r, l, k, v, a, k2; };
constexpr size_t WS_RWX = WS_W_IN;
static_assert((size_t)128 * 64 * 2 * 32 * 8 <= (size_t)NPROJ * 1024 * 2, "rwkv exchange");
template <bool HALF> DI void rwkv_job(const Ctx& C, int seq, int hd, int half, bool dry) {
    const int tid = opaque_tid(), lane = tid & 63, w = C.wave;
    const bool prompt = seq < NBP; const int b = prompt ? seq : seq - NBP; const int start = prompt ? seq * SEQP : MP + b * SEQS; const int len = prompt ? SEQP : SEQS;
    const bf16_t* R = (const bf16_t*)(C.ws + WS_R); const bf16_t* Kb = (const bf16_t*)(C.ws + WS_K); bf16_t* Vb = (bf16_t*)(C.ws + WS_V);
    const bf16_t* LD = (const bf16_t*)(C.ws + WS_LD); const bf16_t* AA = (const bf16_t*)(C.ws + WS_AA);
    constexpr int TC = 32, ARR = TC * 64, BUFF = 7 * ARR + TC * 8 + 64;
    LAS float* L0 = (LAS float*)C.lds;
    const int nch = (len + TC - 1) / TC;
    if (w < 4) {
        const int cg = lane & 7; const int row = HALF ? (8 * w + (lane >> 3)) : 2 * (8 * w + (lane >> 3));
        f32x2 s[4], s1[4];
#pragma unroll
        for (int e = 0; e < 4; ++e) { s[e] = (f32x2){0.f, 0.f}; s1[e] = (f32x2){0.f, 0.f}; }
        if (!HALF && !prompt) { const float* s0 = C.in[I_RWKV] + ((size_t)(b * 16 + hd) * 64 + row) * 64 + 8 * cg;
#pragma unroll
            for (int e = 0; e < 4; ++e) { s[e] = *(const f32x2*)(s0 + 2 * e); s1[e] = *(const f32x2*)(s0 + 64 + 2 * e); } }
        LBAR();
        float sa = 0.f, sb = 0.f;
        if (!HALF) { const LAS float* a0p = L0 + 7 * ARR + TC * 8 + 8 * cg; const f32x4 a0 = *(const LAS f32x4*)a0p, a1 = *(const LAS f32x4*)(a0p + 4);
          const f32x2 A0 = {a0.x, a0.y}, A1 = {a0.z, a0.w}, A2 = {a1.x, a1.y}, A3 = {a1.z, a1.w};
          const f32x2 t0 = (s[0] * A0 + s[1] * A1) + (s[2] * A2 + s[3] * A3), t1 = (s1[0] * A0 + s1[1] * A1) + (s1[2] * A2 + s1[3] * A3);
          sa = sum8_dpp(t0.x + t0.y); sb = sum8_dpp(t1.x + t1.y); }
#pragma unroll 1
        for (int c = 0; c < nch; ++c) {
            const int ntok = (len - c * TC) < TC ? (len - c * TC) : TC;
            LAS float* B_ = L0 + (c & 1) * BUFF; LAS float* Wd = B_; LAS float* WA = B_ + ARR; LAS float* Bm = B_ + 2 * ARR; LAS float* Kp = B_ + 3 * ARR; LAS float* WR = B_ + 4 * ARR; LAS float* Vv = B_ + 5 * ARR; LAS float* Yv = B_ + 6 * ARR; LAS float* Sc = B_ + 7 * ARR;
#define RW_DECL(P) f32x4 P##w0, P##w1, P##a0, P##a1, P##b0, P##b1, P##k0, P##k1, P##r0, P##r1, P##sc; f32x2 P##vi;
#define RW_LOAD(P, t) { P##w0 = *(const LAS f32x4*)(Wd + (t) * 64 + 8 * cg); P##w1 = *(const LAS f32x4*)(Wd + (t) * 64 + 8 * cg + 4); P##a0 = *(const LAS f32x4*)(WA + (t) * 64 + 8 * cg); P##a1 = *(const LAS f32x4*)(WA + (t) * 64 + 8 * cg + 4); \
                P##b0 = *(const LAS f32x4*)(Bm + (t) * 64 + 8 * cg); P##b1 = *(const LAS f32x4*)(Bm + (t) * 64 + 8 * cg + 4); P##k0 = *(const LAS f32x4*)(Kp + (t) * 64 + 8 * cg); P##k1 = *(const LAS f32x4*)(Kp + (t) * 64 + 8 * cg + 4); \
                P##r0 = *(const LAS f32x4*)(WR + (t) * 64 + 8 * cg); P##r1 = *(const LAS f32x4*)(WR + (t) * 64 + 8 * cg + 4); P##sc = *(const LAS f32x4*)(Sc + (t) * 8); \
                if (HALF) { P##vi.x = Vv[(t) * 64 + row]; P##vi.y = 0.f; } else P##vi = *(const LAS f32x2*)(Vv + (t) * 64 + row); }
#define RW_STEP(P, t) { \
                const f32x2 A0 = {P##a0.x, P##a0.y}, A1 = {P##a0.z, P##a0.w}, A2 = {P##a1.x, P##a1.y}, A3 = {P##a1.z, P##a1.w}, R0 = {P##r0.x, P##r0.y}, R1 = {P##r0.z, P##r0.w}, R2 = {P##r1.x, P##r1.y}, R3 = {P##r1.z, P##r1.w}; \
                const f32x2 B0 = {P##b0.x, P##b0.y}, B1 = {P##b0.z, P##b0.w}, B2 = {P##b1.x, P##b1.y}, B3 = {P##b1.z, P##b1.w}, K0 = {P##k0.x, P##k0.y}, K1 = {P##k0.z, P##k0.w}, K2 = {P##k1.x, P##k1.y}, K3 = {P##k1.z, P##k1.w}; \
                const f32x2 W0 = {P##w0.x, P##w0.y}, W1 = {P##w0.z, P##w0.w}, W2 = {P##w1.x, P##w1.y}, W3 = {P##w1.z, P##w1.w}; \
                const f32x2 sa2 = (s[0] * A0 + s[1] * A1) + (s[2] * A2 + s[3] * A3), yw2 = (s[0] * R0 + s[1] * R1) + (s[2] * R2 + s[3] * R3); \
                const f32x2 sav = {sa, sa}, viv = {P##vi.x, P##vi.x}; \
                s[0] = s[0] * W0 + (sav * B0 + viv * K0); s[1] = s[1] * W1 + (sav * B1 + viv * K1); s[2] = s[2] * W2 + (sav * B2 + viv * K2); s[3] = s[3] * W3 + (sav * B3 + viv * K3); \
                if (HALF) { \
                    const float d2a = sum8_dpp(sa2.x + sa2.y), d1a = sum8_dpp(yw2.x + yw2.y); \
                    Yv[(t) * 64 + row] = d1a + sa * P##sc.z + P##vi.x * P##sc.w; \
                    sa = d2a + sa * P##sc.x + P##vi.x * P##sc.y; \
                } else { \
                    const f32x2 sb2 = (s1[0] * A0 + s1[1] * A1) + (s1[2] * A2 + s1[3] * A3), yx2 = (s1[0] * R0 + s1[1] * R1) + (s1[2] * R2 + s1[3] * R3); \
                    const f32x2 sbv = {sb, sb}, vjv = {P##vi.y, P##vi.y}; \
                    s1[0] = s1[0] * W0 + (sbv * B0 + vjv * K0); s1[1] = s1[1] * W1 + (sbv * B1 + vjv * K1); s1[2] = s1[2] * W2 + (sbv * B2 + vjv * K2); s1[3] = s1[3] * W3 + (sbv * B3 + vjv * K3); \
                    const float d2a = sum8_dpp(sa2.x + sa2.y), d2b = sum8_dpp(sb2.x + sb2.y), d1a = sum8_dpp(yw2.x + yw2.y), d1b = sum8_dpp(yx2.x + yx2.y); \
                    *(LAS f32x2*)(Yv + (t) * 64 + row) = (f32x2){d1a + sa * P##sc.z + P##vi.x * P##sc.w, d1b + sb * P##sc.z + P##vi.y * P##sc.w}; \
                    sa = d2a + sa * P##sc.x + P##vi.x * P##sc.y; sb = d2b + sb * P##sc.x + P##vi.y * P##sc.y; } }
            RW_DECL(p) RW_DECL(n) RW_DECL(p2) RW_DECL(n2)
            RW_LOAD(p, 0) RW_LOAD(n, 1)
            for (int t = 0; t < ntok; t += 4) {
                RW_LOAD(p2, t + 2) RW_LOAD(n2, t + 3)
                RW_STEP(p, t) RW_STEP(n, t + 1)
                RW_LOAD(p, t + 4) RW_LOAD(n, t + 5)
                RW_STEP(p2, t + 2) RW_STEP(n2, t + 3)
            }
#undef RW_DECL
#undef RW_LOAD
#undef RW_STEP
            LBAR();
        }
        if (!dry) { float* so = C.out + (prompt ? O_P_RWKV : O_S_RWKV) + ((size_t)(b * 16 + hd) * 64 + half * 32 + row) * 64 + 8 * cg;
#pragma unroll
            for (int e = 0; e < 4; ++e) { *(f32x2*)(so + 2 * e) = s[e]; if (!HALF) *(f32x2*)(so + 64 + 2 * e) = s1[e]; } }
    } else {
        const int bt = tid - 256, tl0 = bt >> 4, l16 = bt & 15, ch = hd * 64 + 4 * l16;
        const f32x4 kkw = *(const f32x4*)(C.in[I_KK] + ch), kaw = *(const f32x4*)(C.in[I_KA] + ch), rkw = *(const f32x4*)(C.in[I_RK] + ch);
        const bool pact = !HALF || l16 < 8; const int pch = hd * 64 + half * 32 + 4 * l16;
        f32x4 lnw = {0.f, 0.f, 0.f, 0.f}, lnb = {0.f, 0.f, 0.f, 0.f};
        if (pact) { lnw = *(const f32x4*)(C.in[I_LNW] + pch); lnb = *(const f32x4*)(C.in[I_LNB] + pch); }
        float* xb = (float*)(C.ws + WS_RWX) + (size_t)(seq * 16 + hd) * (64 * 2 * 32 * 2);
        RwRaw raw[2];
        auto load_raw = [&](int c) {
#pragma unroll
            for (int hh = 0; hh < 2; ++hh) { const int t = c * TC + tl0 + 16 * hh; RwRaw z; z.r = z.l = z.k = z.v = z.a = z.k2 = (u32x2){0u, 0u};
                if (t < len) { const size_t off = (size_t)(start + t) * D + ch; z.r = *(const u32x2*)(R + off); z.l = *(const u32x2*)(LD + off); z.k = *(const u32x2*)(Kb + off); z.v = *(const u32x2*)(Vb + off); z.a = *(const u32x2*)(AA + off);
                    if (t + 1 < len) z.k2 = *(const u32x2*)(Kb + off + D); }
                raw[hh] = z; } };
        auto prep = [&](int c) {
            LAS float* B_ = L0 + (c & 1) * BUFF;
#pragma unroll
            for (int hh = 0; hh < 2; ++hh) { const int tl = tl0 + 16 * hh; const RwRaw z = raw[hh];
                const float rr[4] = {bf_lo(z.r.x), bf_hi(z.r.x), bf_lo(z.r.y), bf_hi(z.r.y)}; const float wd[4] = {__expf(bf_lo(z.l.x)), __expf(bf_hi(z.l.x)), __expf(bf_lo(z.l.y)), __expf(bf_hi(z.l.y))};
                const float kr_[4] = {bf_lo(z.k.x), bf_hi(z.k.x), bf_lo(z.k.y), bf_hi(z.k.y)}; const float vv[4] = {bf_lo(z.v.x), bf_hi(z.v.x), bf_lo(z.v.y), bf_hi(z.v.y)}; const float aa[4] = {bf_lo(z.a.x), bf_hi(z.a.x), bf_lo(z.a.y), bf_hi(z.a.y)};
                const float kn_[4] = {bf_lo(z.k2.x), bf_hi(z.k2.x), bf_lo(z.k2.y), bf_hi(z.k2.y)};
                float kk[4], kp[4], k2[4], ss = 0.f, ss2 = 0.f;
#pragma unroll
                for (int e = 0; e < 4; ++e) { kk[e] = kr_[e] * kkw[e]; ss += kk[e] * kk[e]; kp[e] = kr_[e] * (1.f + (aa[e] - 1.f) * kaw[e]); k2[e] = kn_[e] * kkw[e]; ss2 += k2[e] * k2[e]; }
                ss = sum16(ss); ss2 = sum16(ss2); const float rs = __builtin_amdgcn_rsqf(ss + NORM_EPS), rs2 = __builtin_amdgcn_rsqf(ss2 + NORM_EPS);
                float br = 0.f, kr = 0.f, bo = 0.f, ga = 0.f, de = 0.f; f32x4 am, an, bm, wr4, wa4, kp4, wd4, vv4;
#pragma unroll
                for (int e = 0; e < 4; ++e) { const float kn = kk[e] * rs; am[e] = -kn; an[e] = -k2[e] * rs2; bm[e] = kn * aa[e]; wr4[e] = wd[e] * rr[e]; wa4[e] = wd[e] * an[e]; kp4[e] = kp[e]; wd4[e] = wd[e]; vv4[e] = vv[e];
                    br += bm[e] * rr[e]; kr += kp[e] * rr[e]; bo += rr[e] * kp[e] * rkw[e]; ga += bm[e] * an[e]; de += kp[e] * an[e]; }
                br = sum16(br); kr = sum16(kr); bo = sum16(bo); ga = sum16(ga); de = sum16(de);
                *(LAS f32x4*)(B_ + tl * 64 + 4 * l16) = wd4; *(LAS f32x4*)(B_ + ARR + tl * 64 + 4 * l16) = wa4; *(LAS f32x4*)(B_ + 2 * ARR + tl * 64 + 4 * l16) = bm;
                *(LAS f32x4*)(B_ + 3 * ARR + tl * 64 + 4 * l16) = kp4; *(LAS f32x4*)(B_ + 4 * ARR + tl * 64 + 4 * l16) = wr4;
                if (!HALF) *(LAS f32x4*)(B_ + 5 * ARR + tl * 64 + 4 * l16) = vv4;
                else if ((l16 >> 3) == half) *(LAS f32x4*)(B_ + 5 * ARR + tl * 64 + 4 * (l16 & 7)) = vv4;
                if (l16 == 0) { *(LAS f32x4*)(B_ + 7 * ARR + tl * 8) = (f32x4){ga, de, br, kr}; B_[7 * ARR + tl * 8 + 4] = bo; }
                if (tl == 0) *(LAS f32x4*)(B_ + 7 * ARR + TC * 8 + 4 * l16) = am; } };
        struct PostRegs { float y[2][4], v[2][4], bo[2], sum[2], sq[2]; };
        PostRegs cur, prev;
        auto post1 = [&](int c, PostRegs& P) {
            LAS float* B_ = L0 + (c & 1) * BUFF; const int ntok = (len - c * TC) < TC ? (len - c * TC) : TC;
#pragma unroll
            for (int hh = 0; hh < 2; ++hh) { const int tl = tl0 + 16 * hh;
#pragma unroll
                for (int e = 0; e < 4; ++e) { P.y[hh][e] = 0.f; P.v[hh][e] = 0.f; }
                P.bo[hh] = 0.f;
                if (tl < ntok && pact) { const f32x4 yv = *(const LAS f32x4*)(B_ + 6 * ARR + tl * 64 + 4 * l16), v4 = *(const LAS f32x4*)(B_ + 5 * ARR + tl * 64 + 4 * l16); P.bo[hh] = B_[7 * ARR + tl * 8 + 4];
#pragma unroll
                    for (int e = 0; e < 4; ++e) { P.y[hh][e] = yv[e]; P.v[hh][e] = v4[e]; } }
                P.sum[hh] = sum16((P.y[hh][0] + P.y[hh][1]) + (P.y[hh][2] + P.y[hh][3]));
                P.sq[hh] = sum16((P.y[hh][0] * P.y[hh][0] + P.y[hh][1] * P.y[hh][1]) + (P.y[hh][2] * P.y[hh][2] + P.y[hh][3] * P.y[hh][3]));
                if (HALF && l16 == 0) { unsigned long long* slot = (unsigned long long*)(xb + ((size_t)(c * 2 + half) * 32 + tl) * 2);
                    __hip_atomic_store(slot, ((unsigned long long)__float_as_uint(P.sq[hh]) << 32) | __float_as_uint(P.sum[hh]), __ATOMIC_RELAXED, __HIP_MEMORY_SCOPE_AGENT); } } };
        auto load_px = [&](int c, unsigned long long (&px)[2]) {
#pragma unroll
            for (int hh = 0; hh < 2; ++hh) px[hh] = __hip_atomic_load((const unsigned long long*)(xb + ((size_t)(c * 2 + (half ^ 1)) * 32 + tl0 + 16 * hh) * 2), __ATOMIC_RELAXED, __HIP_MEMORY_SCOPE_AGENT); };
        auto post2 = [&](int c, const PostRegs& P, unsigned long long (&px)[2]) {
            const int ntok = (len - c * TC) < TC ? (len - c * TC) : TC;
#pragma unroll
            for (int hh = 0; hh < 2; ++hh) { const int tl = tl0 + 16 * hh; float tsum = P.sum[hh], tsq = P.sq[hh];
                if (HALF) { unsigned sp = 0;
                    while (px[hh] == ~0ull) { __builtin_amdgcn_s_sleep(1); px[hh] = __hip_atomic_load((const unsigned long long*)(xb + ((size_t)(c * 2 + (half ^ 1)) * 32 + tl) * 2), __ATOMIC_RELAXED, __HIP_MEMORY_SCOPE_AGENT); if (++sp > (1u << 20)) break; }
                    tsum += __uint_as_float((unsigned)px[hh]); tsq += __uint_as_float((unsigned)(px[hh] >> 32)); }
                const float mu = tsum * (1.f / 64.f); const float var = fmaxf(tsq * (1.f / 64.f) - mu * mu, 0.f); const float rstd = __builtin_amdgcn_rsqf(var + 64e-5f);
                if (tl < ntok && pact && !dry) { float o[4];
#pragma unroll
                    for (int e = 0; e < 4; ++e) o[e] = (P.y[hh][e] - mu) * rstd * lnw[e] + lnb[e] + P.bo[hh] * P.v[hh][e];
                    u32x2 pk; pk.x = pk2(o[0], o[1]); pk.y = pk2(o[2], o[3]); *(u32x2*)(Vb + (size_t)(start + c * TC + tl) * D + pch) = pk; } } };
        unsigned long long px[2] = {0ull, 0ull};
        load_raw(0); prep(0); load_raw(1);
        LBAR();
#pragma unroll 1
        for (int c = 0; c < nch; ++c) {
            if (HALF && c >= 2) load_px(c - 2, px);
            if (c >= 1) post1(c - 1, cur);
            if (c + 1 < nch) prep(c + 1);
            if (HALF) { if (c >= 2) post2(c - 2, prev, px); } else { if (c >= 1) post2(c - 1, cur, px); }
            if (c + 1 < nch) load_raw(c + 2);
            prev = cur;
            LBAR();
        }
        if (HALF) { if (nch >= 2) load_px(nch - 2, px);
            post1(nch - 1, cur);
            if (nch >= 2) post2(nch - 2, prev, px);
            load_px(nch - 1, px); post2(nch - 1, cur, px); }
        else { post1(nch - 1, cur); post2(nch - 1, cur, px); }
    }
    LBAR();
}

constexpr size_t WS_BAR = 59 * MiB;
static_assert(WS_W_END <= WS_BAR, "barrier words");
#define XB_TMO      128
#define XB_XCNT(j)  (256  + 64 * (j))
#define XB_XSUB(j)  (1280 + 64 * (j))
#define XB_XGEN(j)  (2304 + 64 * (j))
#define XB_TOP      3328
#define XB_TOPGEN   3392
#define XCD_BAR_WORDS 3456
#define XB_SPIN_CAP (1u << 20)
DI unsigned xb_ld(unsigned* p)              { return __hip_atomic_load(p, __ATOMIC_RELAXED, __HIP_MEMORY_SCOPE_AGENT); }
DI unsigned xb_add(unsigned* p, unsigned v) { return __hip_atomic_fetch_add(p, v, __ATOMIC_RELAXED, __HIP_MEMORY_SCOPE_AGENT); }
DI unsigned xb_xcc_id() { return (unsigned)__builtin_amdgcn_s_getreg((3 << 11) | 20) & 0xFu; }
#define XB_SPIN(cond, bar) do { unsigned _sp = 0; while (cond) { __builtin_amdgcn_s_sleep(1); \
    if ((++_sp & 255u) == 0u) { if (xb_ld(&(bar)[XB_TMO])) break; if (_sp > XB_SPIN_CAP) { atomicAdd(&(bar)[XB_TMO], 1u); break; } } } } while (0)
struct XcdBarrier { unsigned* bar; unsigned x; volatile LAS unsigned* st; };
DI XcdBarrier xcd_barrier_post(unsigned* bar, volatile LAS unsigned* st) {
    XcdBarrier b; b.bar = bar; b.x = xb_xcc_id(); b.st = st;
    if (threadIdx.x == 0) (void)xb_add(&bar[XB_XCNT(b.x)], 1u);
    return b;
}
DI void xcd_barrier_complete(unsigned* bar, unsigned x, unsigned& nloc, unsigned& nx) {
    const unsigned G = gridDim.x * gridDim.y * gridDim.z;
    unsigned sum, cnt, mine, sp = 0u;
    for (;;) {
        sum = 0u; cnt = 0u; mine = 0u;
#pragma unroll
        for (unsigned j = 0; j < 16; ++j) { const unsigned c = xb_ld(&bar[XB_XCNT(j)]); sum += c; cnt += (c > 0u) ? 1u : 0u; mine = (j == x) ? c : mine; }
        if (sum == G) break;
        __builtin_amdgcn_s_sleep(1);
        if ((++sp & 255u) == 0u) { if (xb_ld(&bar[XB_TMO])) break; if (sp > XB_SPIN_CAP) { atomicAdd(&bar[XB_TMO], 1u); break; } }
    }
    nloc = mine > 0u ? mine : 1u; nx = cnt > 0u ? cnt : 1u;
}
DI void xcd_barrier(const XcdBarrier& b) {
    asm volatile("s_waitcnt vmcnt(0)" ::: "memory");
    __syncthreads();
    if (threadIdx.x == 0) {
        unsigned* bar = b.bar;
        __builtin_amdgcn_s_waitcnt(0);
        unsigned nloc = b.st[0], nx = b.st[1];
        if (nloc == 0u) { xcd_barrier_complete(bar, b.x, nloc, nx); b.st[0] = nloc; b.st[1] = nx; }
        const unsigned old = xb_add(&bar[XB_XSUB(b.x)], 1u);
        const unsigned gen = old / nloc;
        if (old + 1u == (gen + 1u) * nloc) {
            __builtin_amdgcn_fence(__ATOMIC_RELEASE, "agent");
            asm volatile("s_waitcnt vmcnt(0)" ::: "memory");
            const unsigned og = xb_add(&bar[XB_TOP], 1u);
            const unsigned tg = og / nx;
            if (og + 1u == (tg + 1u) * nx) xb_add(&bar[XB_TOPGEN], 1u);
            else XB_SPIN(xb_ld(&bar[XB_TOPGEN]) == tg, bar);
            __builtin_amdgcn_fence(__ATOMIC_ACQUIRE, "agent");
            xb_add(&bar[XB_XGEN(b.x)], 1u);
            asm volatile("s_waitcnt vmcnt(0)" ::: "memory");
        } else {
            XB_SPIN(xb_ld(&bar[XB_XGEN(b.x)]) == gen, bar);
            __builtin_amdgcn_fence(__ATOMIC_ACQUIRE, "agent");
            asm volatile("s_waitcnt vmcnt(0)" ::: "memory");
        }
    }
    __syncthreads();
}

#ifndef PH_MASK
#define PH_MASK 0xFFFFFFFFu
#endif
#define PH(k) ((PH_MASK >> (k)) & 1u)
#ifndef REP_MASK
#define REP_MASK 0u
#endif
#ifndef NSYNC_EXTRA
#define NSYNC_EXTRA 0
#endif
#define REP(k) ((REP_MASK >> (k)) & 1u)
#define PHASE(k, ...) _Pragma("unroll 1") for (int rep_ = 0; rep_ <= (int)REP(k); ++rep_) { if (PH(k)) { __VA_ARGS__ } GSYNC(); }
#define PHASE1(k, ...) { if (PH(k)) { __VA_ARGS__ } GSYNC(); }
#define GSYNC() xcd_barrier(xbar)
#define PHASED(k, ...) _Pragma("unroll 1") for (int rep_ = 0; rep_ <= (int)REP(k); ++rep_) { const int dry_ = rep_ < (int)REP(k); if (PH(k)) { __VA_ARGS__ } GSYNC(); }
template <int MODE> DI void run_gemm(const Ctx& C, const bf16_t* A, int lda, const bf16_t* Bt, int ldb, int N, int K, const Epi<MODE>& E, int split = 0, int Mrows = M) {
    pg8::Gemm g{A, Bt, Mrows, N, K, lda, ldb}; pg8::StaticOrder S; S.init(Mrows, N, C.G, C.blk, K, split);
    pg8::gemm_phase<Epi<MODE>, true, MODE == EP_ATOM>(C.lds, g, S, E);
}

__global__ void __launch_bounds__(512, 2) fwd_megakernel(Args args) {
    extern __shared__ __attribute__((aligned(16))) unsigned char lds_raw[];
    cg::grid_group grid = cg::this_grid();
    Ctx C; C.in = args.in; C.out = args.out; C.ws = args.ws; C.lds = (LAS unsigned char*)lds_raw;
    C.tid = threadIdx.x; C.lane = C.tid & 63; C.wave = __builtin_amdgcn_readfirstlane(C.tid >> 6); C.G = gridDim.x; C.blk = blockIdx.x;
    unsigned char* ws = args.ws;
    bf16_t* W_IN = (bf16_t*)(ws + WS_W_IN); bf16_t* W_GLU = (bf16_t*)(ws + WS_W_GLU); bf16_t* W_OUT = (bf16_t*)(ws + WS_W_OUT);
    bf16_t* W_GU0 = (bf16_t*)(ws + WS_W_GU0); bf16_t* W_DN0 = (bf16_t*)(ws + WS_W_DN0); bf16_t* W_GU1 = (bf16_t*)(ws + WS_W_GU1); bf16_t* W_DN1 = (bf16_t*)(ws + WS_W_DN1);
    bf16_t* W_RW1 = (bf16_t*)(ws + WS_W_RW1); bf16_t* W_RW2 = (bf16_t*)(ws + WS_W_RW2); bf16_t* W_G2 = (bf16_t*)(ws + WS_W_G2); bf16_t* W_O = (bf16_t*)(ws + WS_W_O);
    bf16_t* HB = (bf16_t*)(ws + WS_HB); bf16_t* PROJ = (bf16_t*)(ws + WS_PROJ); bf16_t* CAT = (bf16_t*)(ws + WS_CAT);
    bf16_t* Rb = (bf16_t*)(ws + WS_R); bf16_t* Kb = (bf16_t*)(ws + WS_K); bf16_t* Vb = (bf16_t*)(ws + WS_V); bf16_t* LDb = (bf16_t*)(ws + WS_LD); bf16_t* AAb = (bf16_t*)(ws + WS_AA);
    bf16_t* LMWA = (bf16_t*)(ws + WS_LMWA); bf16_t* LMG = (bf16_t*)(ws + WS_LMG);
    float* X = args.out + O_Y;
    volatile LAS unsigned* xst = (volatile LAS unsigned*)(C.lds + (LDS_BYTES - 64));
    if (C.tid < 16) xst[C.tid] = 0u;
    __syncthreads();
    const XcdBarrier xbar = xcd_barrier_post((unsigned*)(ws + WS_BAR), xst);
    const bool RS_SPLIT = (C.G == 256); const int RS_M = RS_SPLIT ? MP : M;
    if (args.ws == nullptr) grid.sync();

    PHASE(0,
    tr_all(C, 0, 1, 0);
    zero_rect(C, W_IN, 1024, 2568, NPROJ - 2568, 0, 1024);
    rms_rows<0>(C, C.in[I_XP], C.in[I_XS], C.in[I_NMIX], HB);
    )
    PHASE(1, Epi<EP_BF16> E{}; E.O = PROJ; E.ldo = NPROJ; run_gemm<EP_BF16>(C, HB, 1024, W_IN, 1024, NPROJ, 1024, E); )
    PHASE(2,
    if (PH(20)) for (int j = C.blk; j < 1024 + NBS * 4; j += C.G) { if (j < 1024) gdn_unit(C, j >> 7, ((j >> 2) & 31) * 64, j & 3); else gdn_unit(C, NBP + ((j - 1024) >> 2), 0, j & 3); }
    __syncthreads();
    if (PH(21)) for (int j = C.blk * 8 + C.wave; j < NBS * 32 + 2048; j += C.G * 8) { if (j < NBS * 32) s5_unit<2>(C, NBP + (j >> 5), j & 31, 0); else { const int k = j - NBS * 32; s5_unit<1>(C, k >> 8, (k >> 3) & 31, k & 7); } }
    )
    PHASE(18,
    if (C.blk < 64) { if (PH(20)) gdn_seq(C, C.blk >> 3, (C.blk >> 1) & 3, C.blk & 1); }
    else { if (PH(21)) for (int k = (C.blk - 64) * 8 + C.wave; k < 2048; k += (C.G - 64) * 8) s5_unit<2>(C, k >> 8, (k >> 3) & 31, k & 7); }
    if (C.blk >= 64 && rep_ == 0) { __syncthreads();
        tr_all(C, 1, NTJ, 64);
        zero_rect(C, W_RW1, 2048, 3200, 128, 0, 2048, 64);
        zero_rect(C, W_RW1, 2048, 3488, 96, 0, 2048, 64);
        zero_rect(C, W_RW2, 128, 0, 1024, 64, 64, 64);
        zero_rect(C, W_RW2, 128, 1024, 1024, 0, 64, 64);
        zero_rect(C, W_G2, 256, 0, 1024, 192, 64, 64); }
    )
    PHASE(3, constexpr int GP1 = 37632;
        if (C.blk >= 136) gdn_post(C, 136, 0, GP1); else { Epi<EP_GLU> E{}; E.O = CAT; E.ldo = D; E.X = (const bf16_t*)(ws + WS_YG); E.ldx = 512; run_gemm<EP_GLU>(C, (const bf16_t*)(ws + WS_YG), 512, W_GLU, 512, 512, 512, E); } gdn_post(C, 0, GP1, M * 4); )
    PHASE(4, Epi<EP_RESID> E{}; E.baseP = C.in[I_XP]; E.baseS = C.in[I_XS]; E.out = X; run_gemm<EP_RESID>(C, CAT, D, W_OUT, 1024, 1024, 1024, E, 0, RS_M); if (RS_SPLIT) { Epi<EP_ATOM> E2{}; E2.out = (float*)(ws + WS_PROJ); E2.dry = E.dry; run_gemm<EP_ATOM>(C, CAT, D, W_OUT, 1024, 1024, 1024, E2, 8, M); } )
    PHASE(5, rms_rows<0>(C, X, X + (size_t)MP * D, C.in[I_NFFN], HB, RS_SPLIT ? (const float*)(ws + WS_PROJ) : nullptr, 8, C.in[I_XS]); )
    PHASE(6, Epi<EP_SWIGLU> E{}; E.O = PROJ; E.ldo = DFF; run_gemm<EP_SWIGLU>(C, HB, 1024, W_GU0, 1024, 2 * DFF, 1024, E); )
    PHASED(7, Epi<EP_RESID> E{}; E.dry = dry_; E.baseP = X; E.baseS = X + (size_t)MP * D; E.out = X; run_gemm<EP_RESID>(C, PROJ, DFF, W_DN0, DFF, 1024, DFF, E, 0, RS_M); if (RS_SPLIT) { Epi<EP_ATOM> E2{}; E2.out = (float*)(ws + WS_CAT); E2.dry = E.dry; run_gemm<EP_ATOM>(C, PROJ, DFF, W_DN0, DFF, 1024, DFF, E2, 11, M); } )
    PHASE(8, rms_rows<1>(C, X, X + (size_t)MP * D, C.in[I_NMIX] + D, HB, RS_SPLIT ? (const float*)(ws + WS_CAT) : nullptr, 11, X + (size_t)MP * D);
        for (int e = C.blk * 512 + C.tid; e < 128 * 64 * 2 * 32 * 8 / 16; e += C.G * 512) *(u32x4*)(ws + WS_RWX + (size_t)e * 16) = (u32x4){~0u, ~0u, ~0u, ~0u}; )
    PHASE(9, Epi<EP_RW1> E{}; E.O = Rb; E.O4 = LMWA; E.O5 = LMG; run_gemm<EP_RW1>(C, HB, 2048, W_RW1, 2048, NRW1, 2048, E); )
    PHASE(10, Epi<EP_RW2> E{}; E.O = LDb; E.v0 = C.in[I_W0]; E.v1 = C.in[I_A0]; run_gemm<EP_RW2>(C, LMWA, 128, W_RW2, 128, 2048, 128, E); )
    PHASED(11,
    for (int j = C.blk; j < NBS * 16; j += C.G) rwkv_job<false>(C, NBP + (j >> 4), j & 15, 0, dry_);
    rwkv_job<true>(C, C.blk >> 5, (C.blk >> 1) & 15, C.blk & 1, dry_);
    )
    PHASED(12, Epi<EP_GATE> E{}; E.dry = dry_; E.O = Vb; E.ldo = D; run_gemm<EP_GATE>(C, LMG, 256, W_G2, 256, 1024, 256, E); )
    PHASED(13, Epi<EP_RESID> E{}; E.dry = dry_; E.baseP = X; E.baseS = X + (size_t)MP * D; E.out = X; run_gemm<EP_RESID>(C, Vb, D, W_O, 1024, 1024, 1024, E, 0, RS_M); if (RS_SPLIT) { Epi<EP_ATOM> E2{}; E2.out = (float*)(ws + WS_AA); E2.dry = E.dry; run_gemm<EP_ATOM>(C, Vb, D, W_O, 1024, 1024, 1024, E2, 8, M); } )
    PHASE(14, rms_rows<0>(C, X, X + (size_t)MP * D, C.in[I_NFFN] + D, HB, RS_SPLIT ? (const float*)(ws + WS_AA) : nullptr, 8, X + (size_t)MP * D); )
    PHASE(15, Epi<EP_SWIGLU> E{}; E.O = PROJ; E.ldo = DFF; run_gemm<EP_SWIGLU>(C, HB, 1024, W_GU1, 1024, 2 * DFF, 1024, E); )
    PHASED(16, Epi<EP_RESID> E{}; E.dry = dry_; E.baseP = X; E.baseS = X + (size_t)MP * D; E.out = X; run_gemm<EP_RESID>(C, PROJ, DFF, W_DN1, DFF, 1024, DFF, E, 0, RS_M); if (RS_SPLIT) { Epi<EP_ATOM> E2{}; E2.out = (float*)(ws + WS_CAT); E2.dry = E.dry; run_gemm<EP_ATOM>(C, PROJ, DFF, W_DN1, DFF, 1024, DFF, E2, 11, M); } )
    for (int xs = 0; xs < NSYNC_EXTRA; ++xs) GSYNC();
    if (PH(17)) rms_rows<2>(C, X, X + (size_t)MP * D, C.in[I_NFIN], nullptr, RS_SPLIT ? (const float*)(ws + WS_CAT) : nullptr, 11, X + (size_t)MP * D);
}

extern "C" void kernel_launch(void* const* d_in, const int* in_sizes, int n_in, void* d_out, int out_size, void* d_ws, size_t ws_size, hipStream_t stream) {
    static int grid = 0;
    if (grid == 0) {
        if (n_in != 47 || (size_t)out_size != O_END || ws_size < WS_END) { fprintf(stderr, "kernel_launch: unexpected shapes n_in %d out %d ws %zu\n", n_in, out_size, ws_size); grid = -1; return; }
        int dev = 0, cus = 0, per_cu = 0;
        hipGetDevice(&dev); hipDeviceGetAttribute(&cus, hipDeviceAttributeMultiprocessorCount, dev);
        hipFuncSetAttribute((const void*)fwd_megakernel, hipFuncAttributeMaxDynamicSharedMemorySize, LDS_BYTES);
        hipOccupancyMaxActiveBlocksPerMultiprocessor(&per_cu, (const void*)fwd_megakernel, 512, LDS_BYTES);
        (void)hipGetLastError();
        if (per_cu < 1) { fprintf(stderr, "kernel_launch: occupancy query says %d blocks per CU\n", per_cu); per_cu = 1; }
        grid = cus;
    }
    if (grid < 0) return;
    if (hipMemsetAsync((char*)d_ws + WS_BAR, 0, XCD_BAR_WORDS * 4, stream) != hipSuccess) { fprintf(stderr, "kernel_launch: memset of the barrier words failed\n"); return; }
    Args a{};
    for (int i = 0; i < 47; ++i) a.in[i] = (const float*)d_in[i];
    a.out = (float*)d_out; a.ws = (unsigned char*)d_ws;
    void* kargs[] = {&a};
    hipError_t e = hipLaunchCooperativeKernel((const void*)fwd_megakernel, dim3(grid), dim3(512), kargs, LDS_BYTES, stream);
    if (e != hipSuccess) fprintf(stderr, "cooperative launch failed: %s (grid %d)\n", hipGetErrorString(e), grid);
}
```

```cpp
#include <hip/hip_runtime.h>
#include <hip/hip_cooperative_groups.h>
#include <cstdio>
#include <cstdint>
namespace cg = cooperative_groups;

#define DI __device__ __forceinline__
#define LAS __attribute__((address_space(3)))
typedef unsigned short bf16_t;
typedef short bf16x8 __attribute__((ext_vector_type(8)));
typedef float f32x4 __attribute__((ext_vector_type(4)));
typedef float f32x2 __attribute__((ext_vector_type(2)));
typedef unsigned u32x4 __attribute__((ext_vector_type(4)));
typedef unsigned u32x2 __attribute__((ext_vector_type(2)));
typedef __bf16 bf16x2_t __attribute__((ext_vector_type(2)));

constexpr int D = 1024, MP = 16384, MS = 1024, M = MP + MS, SEQP = 2048, SEQS = 8, NBP = 8, NBS = 128, NSEQ = NBP + NBS;
constexpr int DFF = 2816, NPROJ = 2816  , NRW1 = 3584;
constexpr float NORM_EPS = 1e-6f;
constexpr size_t O_Y = 0;
constexpr size_t O_P_S5RE = (size_t)M * D, O_P_S5IM = O_P_S5RE + 8 * 32 * 64, O_P_GDN = O_P_S5IM + 8 * 32 * 64, O_P_CONV = O_P_GDN + (size_t)8 * 4 * 128 * 128,
                 O_P_RWKV = O_P_CONV + 8 * 3 * 1536, O_P_SHIFT = O_P_RWKV + (size_t)8 * 16 * 64 * 64, O_S_S5RE = O_P_SHIFT + 8 * 1024, O_S_S5IM = O_S_S5RE + 128 * 32 * 64,
                 O_S_GDN = O_S_S5IM + 128 * 32 * 64, O_S_CONV = O_S_GDN + (size_t)128 * 4 * 128 * 128, O_S_RWKV = O_S_CONV + 128 * 3 * 1536,
                 O_S_SHIFT = O_S_RWKV + (size_t)128 * 16 * 64 * 64, O_END = O_S_SHIFT + 128 * 1024;
constexpr size_t MiB = 1u << 20;
constexpr size_t WS_W_IN = 1 * MiB, WS_W_GLU = WS_W_IN + (size_t)NPROJ * 1024 * 2, WS_W_OUT = WS_W_GLU + 512 * 512 * 2, WS_W_GU0 = WS_W_OUT + 1024 * 1024 * 2,
                 WS_W_DN0 = WS_W_GU0 + (size_t)5632 * 1024 * 2, WS_W_GU1 = WS_W_DN0 + (size_t)1024 * 2816 * 2, WS_W_DN1 = WS_W_GU1 + (size_t)5632 * 1024 * 2,
                 WS_W_RW1 = WS_W_DN1 + (size_t)1024 * 2816 * 2, WS_W_RW2 = WS_W_RW1 + (size_t)NRW1 * 2048 * 2, WS_W_G2 = WS_W_RW2 + 2048 * 128 * 2,
                 WS_W_O = WS_W_G2 + 1024 * 256 * 2, WS_W_END = WS_W_O + 1024 * 1024 * 2;
static_assert(WS_W_END <= 60 * MiB, "weights");
constexpr size_t WS_HB = 60 * MiB;
constexpr size_t WS_PROJ = 94 * MiB;
constexpr size_t WS_CAT = 188 * MiB;
constexpr size_t WS_LD = 60 * MiB, WS_AA = 94 * MiB;
constexpr size_t WS_R = 128 * MiB, WS_K = 162 * MiB, WS_V = 196 * MiB, WS_LMWA = 230 * MiB, WS_LMG = 235 * MiB, WS_END = 256 * MiB;
static_assert(WS_V - WS_K == WS_K - WS_R, "rkv spacing");
static_assert(WS_LMG + (size_t)M * 256 * 2 <= WS_END && WS_LMWA + (size_t)M * 128 * 2 <= WS_LMG && WS_CAT + (size_t)M * 1024 * 2 <= WS_END, "ws map");
constexpr int LDS_BYTES = 147456;

DI unsigned pk2(float a, float b) { f32x2 v = {a, b}; return __builtin_bit_cast(unsigned, __builtin_convertvector(v, bf16x2_t)); }
DI float bf_lo(unsigned u) { return __builtin_bit_cast(float, u << 16); }
DI float bf_hi(unsigned u) { return __builtin_bit_cast(float, u & 0xffff0000u); }
DI float bf1(bf16_t h) { return __builtin_bit_cast(float, (unsigned)h << 16); }
DI bf16_t f2bf(float f) { return (bf16_t)(pk2(f, 0.f) & 0xffffu); }
DI float sigm(float x) { return __builtin_amdgcn_rcpf(1.f + __expf(-x)); }
DI float siluf(float x) { return x * sigm(x); }
DI float tanh_f(float x) { const float e = __expf(2.f * x); return 1.f - 2.f * __builtin_amdgcn_rcpf(e + 1.f); }
DI float gelu_t(float x) { const float u = 0.7978845608f * (x + 0.044715f * x * x * x); return 0.5f * x * (1.f + tanh_f(u)); }
DI float softplusf(float x) { return fmaxf(x, 0.f) + __logf(1.f + __expf(-fabsf(x))); }

template <int CTRL> DI float dppf(float v) { return __builtin_bit_cast(float, __builtin_amdgcn_update_dpp(0, __builtin_bit_cast(int, v), CTRL, 0xF, 0xF, true)); }
DI float sum16(float v) { v += dppf<0xB1>(v); v += dppf<0x4E>(v); v += dppf<0x141>(v); v += dppf<0x140>(v); return v; }
DI float wave_sum(float v) { v = sum16(v); v += __shfl_xor(v, 16); v += __shfl_xor(v, 32); return v; }
DI float sum8_dpp(float v) { v += dppf<0xB1>(v); v += dppf<0x4E>(v); v += dppf<0x141>(v); return v; }
DI void unpack8(const u32x4 w, float (&x)[8]) { x[0] = bf_lo(w.x); x[1] = bf_hi(w.x); x[2] = bf_lo(w.y); x[3] = bf_hi(w.y); x[4] = bf_lo(w.z); x[5] = bf_hi(w.z); x[6] = bf_lo(w.w); x[7] = bf_hi(w.w); }
DI u32x4 pack8(const float (&x)[8]) { u32x4 w; w.x = pk2(x[0], x[1]); w.y = pk2(x[2], x[3]); w.z = pk2(x[4], x[5]); w.w = pk2(x[6], x[7]); return w; }
DI int opaque_tid() { int t = threadIdx.x; asm volatile("" : "+v"(t)); return t; }
#define LBAR() do { asm volatile("s_waitcnt lgkmcnt(0)" ::: "memory"); __builtin_amdgcn_s_barrier(); asm volatile("" ::: "memory"); } while (0)
#define LDS_WAIT() asm volatile("s_waitcnt lgkmcnt(0)" ::: "memory")
#define MFMA16(a, b, c) __builtin_amdgcn_mfma_f32_16x16x32_bf16((a), (b), (c), 0, 0, 0)

namespace pg8 {
constexpr int BM = 256, BK = 64, HALF = 128, HTB = HALF * BK * 2, STAGE_BYTES = 8 * HTB, NXCD = 8, WGM = 8;
__host__ __device__ __forceinline__ int lds_byte(int r, int c) { const int st = (r >> 4) * 2 + (c >> 5), rr = r & 15, cc = c & 31, ob = rr * 64 + cc * 2; return st * 1024 + (ob ^ (((ob >> 9) & 1) << 5)); }
__host__ __device__ __forceinline__ void stage_rc(int b, int& R, int& C) { const int st = b / 1024, sb = b % 1024, swz = sb ^ (((sb >> 9) & 1) << 5); R = (st >> 1) * 16 + swz / 64; C = (st & 1) * 32 + (swz % 64) / 2; }
__host__ __device__ __forceinline__ int perm32(int rho) { const int n = rho >> 4, i = rho & 15; return 8 * (i >> 2) + 4 * n + (i & 3); }
struct Unit { int pm, pn, kofs, nt, atomic; };
struct Gemm { const bf16_t* A; const bf16_t* Bt; int M, N, K, lda, ldb; };
struct StaticOrder {
    int nM, nN, nwg, G, c, ntK, split;
    __host__ __device__ void init(int M_, int N_, int G_, int c_, int K_, int split_ = 0) { nM = M_ / BM; nN = N_ / BM; nwg = nM * nN; G = G_; c = c_; ntK = K_ / BK; split = split_; }
    __host__ __device__ bool next(int i, Unit& u) const {
        u.kofs = 0; u.nt = ntK; u.atomic = 0;
        if (split) {
            if (i == 0 && c < 16 * split) { const int un = c / split, sl = c - un * split; u.pm = 64 + (un >> 2); u.pn = un & 3; u.nt = ntK / split; u.kofs = sl * u.nt * BK; u.atomic = 1; return true; }
            return false;
        }
        const long L = (long)i * G + c; if (L >= nwg) return false;
        int wgid = (int)L; { const int q = nwg / NXCD, r = nwg % NXCD, xcd = wgid % NXCD, off = wgid / NXCD; wgid = (xcd < r ? xcd * (q + 1) : r * (q + 1) + (xcd - r) * q) + off; }
        const int nig = WGM * nN, gid = wgid / nig, fm = gid * WGM, gsz = (nM - fm) < WGM ? (nM - fm) : WGM;
        u.pm = fm + ((wgid % nig) % gsz); u.pn = (wgid % nig) / gsz; return true;
    }
};
template <class Epi, bool ALIGN_EPI, bool SPLITK = false>
DI void gemm_phase(LAS unsigned char* lds, const Gemm g, const StaticOrder& S, const Epi& E) {
    const int tid = opaque_tid(), wid = __builtin_amdgcn_readfirstlane(tid >> 6), lane = tid & 63, wr = wid >> 2, wc = wid & 3, fr = lane & 15, fq = lane >> 4;
    int K = g.K; asm volatile("" : "+s"(K)); int nt = K / BK;
    unsigned voffA[2], voffB[2];
#pragma unroll
    for (int i = 0; i < 2; ++i) { int R, C; stage_rc(tid * 16 + i * 8192, R, C); const int Rb = Epi::PERM ? ((R & ~31) + perm32(R & 31)) : R;
        voffA[i] = (unsigned)(R * g.lda + C) * 2u; voffB[i] = (unsigned)(Rb * g.ldb + C) * 2u; }
    const size_t kstep = (size_t)(BK * 2);
    const size_t hA = (size_t)HALF * g.lda * 2, hB = (size_t)HALF * g.ldb * 2, tA = 2 * hA, tB = 2 * hB;
    const unsigned ldsw = (unsigned)wid * 1024u;
    const int aoff = lds_byte(wr * 64 + fr, fq * 8), boff = lds_byte(wc * 32 + fr, fq * 8);
#define PG8_SA(b, h) (((b) * 2 + (h)) * HTB)
#define PG8_SB(b, h) ((4 + (b) * 2 + (h)) * HTB)
#define PG8_STAGE(bufoff, gbase, voff) do { _Pragma("unroll") for (int _i = 0; _i < 2; ++_i) \
        __builtin_amdgcn_global_load_lds((const unsigned*)((const char*)(gbase) + (voff)[_i]), (LAS unsigned*)(lds + (bufoff) + ldsw + _i * 8192), 16, 0, 0); } while (0)
#define PG8_LDA(dst, b, h) do { _Pragma("unroll") for (int m = 0; m < 4; ++m) _Pragma("unroll") for (int k = 0; k < 2; ++k) dst[m][k] = *(const LAS bf16x8*)(lds + PG8_SA(b, h) + aoff + m * 2048 + k * 1024); } while (0)
#define PG8_LDB(dst, b, h) do { _Pragma("unroll") for (int n = 0; n < 2; ++n) _Pragma("unroll") for (int k = 0; k < 2; ++k) dst[n][k] = *(const LAS bf16x8*)(lds + PG8_SB(b, h) + boff + n * 2048 + k * 1024); } while (0)
#define PG8_MMA(ai, bj, At, Bt) do { __builtin_amdgcn_s_setprio(1); _Pragma("unroll") for (int m = 0; m < 4; ++m) _Pragma("unroll") for (int n = 0; n < 2; ++n) _Pragma("unroll") for (int k = 0; k < 2; ++k) \
        acc[ai][bj][m][n] = __builtin_amdgcn_mfma_f32_16x16x32_bf16(Bt[n][k], At[m][k], acc[ai][bj][m][n], 0, 0, 0); __builtin_amdgcn_s_setprio(0); } while (0)
#define PG8_WAIT_V(n) asm volatile("s_waitcnt vmcnt(" #n ")" ::: "memory")
#define PG8_WAIT_L(n) asm volatile("s_waitcnt lgkmcnt(" #n ")" ::: "memory")
#define PG8_BAR __builtin_amdgcn_s_barrier()
#define PG8_SCHED __builtin_amdgcn_sched_barrier(0)
    Unit cur, nxt; int ui = 0;
    if (!S.next(0, cur)) return;
    f32x4 acc[2][2][4][2];
#pragma unroll
    for (int a = 0; a < 2; ++a)
#pragma unroll
        for (int b = 0; b < 2; ++b)
#pragma unroll
            for (int m = 0; m < 4; ++m)
#pragma unroll
                for (int n = 0; n < 2; ++n) acc[a][b][m][n] = (f32x4){0.f, 0.f, 0.f, 0.f};
    bf16x8 At[4][2], B0[2][2], B1[2][2];
    const char* cA = (const char*)g.A + (size_t)cur.pm * tA; const char* cB = (const char*)g.Bt + (size_t)cur.pn * tB;
    if constexpr (SPLITK) { cA += (size_t)cur.kofs * 2; cB += (size_t)cur.kofs * 2; nt = cur.nt; }
    PG8_STAGE(PG8_SB(0, 0), cB, voffB); PG8_STAGE(PG8_SB(0, 1), cB + hB, voffB); PG8_STAGE(PG8_SA(0, 0), cA, voffA); PG8_STAGE(PG8_SA(0, 1), cA + hA, voffA);
    if (wr == 1) PG8_BAR;
    PG8_WAIT_V(2); PG8_BAR;
    PG8_STAGE(PG8_SB(1, 0), cB + kstep, voffB); PG8_STAGE(PG8_SA(1, 0), cA + kstep, voffA); PG8_STAGE(PG8_SB(1, 1), cB + hB + kstep, voffB);
    PG8_WAIT_V(6); PG8_BAR;
    for (;;) {
        const bool has_next = S.next(ui + 1, nxt);
        const char* nA = has_next ? (const char*)g.A + (size_t)nxt.pm * tA + (SPLITK ? (size_t)nxt.kofs * 2 : (size_t)0) : cA; const char* nB = has_next ? (const char*)g.Bt + (size_t)nxt.pn * tB + (SPLITK ? (size_t)nxt.kofs * 2 : (size_t)0) : cB;
        for (int t = 0; t < nt; t += 2) {
            const bool last = (t == nt - 2);
            const char* a1 = cA + (size_t)(t + 1) * kstep;
            const char* a2 = last ? nA : cA + (size_t)(t + 2) * kstep; const char* b2 = last ? nB : cB + (size_t)(t + 2) * kstep;
            const char* a3 = a2 + kstep; const char* b3 = b2 + kstep;
            PG8_LDB(B0, 0, 0); PG8_LDB(B1, 0, 1); PG8_SCHED; PG8_LDA(At, 0, 0); PG8_STAGE(PG8_SA(1, 1), a1 + hA, voffA);
            PG8_WAIT_V(8); PG8_WAIT_L(0); PG8_BAR; PG8_MMA(0, 0, At, B0); PG8_MMA(0, 1, At, B1); PG8_BAR; PG8_SCHED;
            PG8_LDA(At, 0, 1); PG8_STAGE(PG8_SB(0, 0), b2, voffB); PG8_STAGE(PG8_SB(0, 1), b2 + hB, voffB); PG8_STAGE(PG8_SA(0, 0), a2, voffA);
            PG8_WAIT_V(8); PG8_WAIT_L(0); PG8_BAR; PG8_MMA(1, 0, At, B0); PG8_MMA(1, 1, At, B1); PG8_BAR; PG8_SCHED;
            PG8_LDB(B0, 1, 0); PG8_LDB(B1, 1, 1); PG8_SCHED; PG8_LDA(At, 1, 0); PG8_STAGE(PG8_SA(0, 1), a2 + hA, voffA);
            PG8_WAIT_V(8); PG8_WAIT_L(0); PG8_BAR; PG8_MMA(0, 0, At, B0); PG8_MMA(0, 1, At, B1); PG8_BAR; PG8_SCHED;
            PG8_LDA(At, 1, 1); PG8_STAGE(PG8_SB(1, 0), b3, voffB); PG8_STAGE(PG8_SB(1, 1), b3 + hB, voffB); PG8_STAGE(PG8_SA(1, 0), a3, voffA);
            PG8_WAIT_V(8); PG8_WAIT_L(0); PG8_BAR; PG8_MMA(1, 0, At, B0); PG8_MMA(1, 1, At, B1); PG8_BAR; PG8_SCHED;
        }
        if constexpr (ALIGN_EPI) { if (wr == 0) PG8_BAR; }
        E(acc, cur, wr, wc, fr, fq);
        if (!has_next) break;
#pragma unroll
        for (int a = 0; a < 2; ++a)
#pragma unroll
            for (int b = 0; b < 2; ++b)
#pragma unroll
                for (int m = 0; m < 4; ++m)
#pragma unroll
                    for (int n = 0; n < 2; ++n) acc[a][b][m][n] = (f32x4){0.f, 0.f, 0.f, 0.f};
        cur = nxt; cA = nA; cB = nB; ++ui; if constexpr (SPLITK) nt = cur.nt;
        if constexpr (ALIGN_EPI) { if (wr == 1) PG8_BAR; }
    }
    PG8_WAIT_V(0);
    if constexpr (!ALIGN_EPI) { if (wr == 0) PG8_BAR; }
    PG8_BAR;
#undef PG8_SA
#undef PG8_SB
#undef PG8_STAGE
#undef PG8_LDA
#undef PG8_LDB
#undef PG8_MMA
#undef PG8_WAIT_V
#undef PG8_WAIT_L
#undef PG8_BAR
#undef PG8_SCHED
}
}

enum { EP_BF16 = 0, EP_GLU, EP_RESID, EP_SWIGLU, EP_RW1, EP_RW2, EP_GATE, EP_ATOM };
template <int MODE> struct Epi {
    static constexpr bool PERM = (MODE != EP_RESID && MODE != EP_ATOM);
    bf16_t* O; int ldo;
    bf16_t *O2, *O3, *O4, *O5;
    const bf16_t* X; int ldx;
    const float* baseP; const float* baseS;
    float* out;
    const float *v0, *v1;
    int dry;
    DI void operator()(const f32x4 (&acc)[2][2][4][2], const pg8::Unit& u, int wr, int wc, int fr, int fq) const {
        const int row0 = u.pm * 256 + wr * 64 + fr;
        if constexpr (MODE == EP_ATOM) {
            const int slice = u.kofs / (u.nt * 64);
            float* op0 = out + ((size_t)slice * MS + (size_t)(row0 - MP)) * D + u.pn * 256 + wc * 32 + 4 * fq;
#pragma unroll
            for (int ai = 0; ai < 2; ++ai)
#pragma unroll
                for (int m = 0; m < 4; ++m)
#pragma unroll
                    for (int bj = 0; bj < 2; ++bj)
#pragma unroll
                        for (int n = 0; n < 2; ++n) *(f32x4*)(op0 + (size_t)(ai * 128 + m * 16) * D + bj * 128 + n * 16) = acc[ai][bj][m][n];
        } else if constexpr (MODE == EP_RESID) {
            const int col0 = u.pn * 256 + wc * 32 + 4 * fq;
#pragma unroll
            for (int ai = 0; ai < 2; ++ai)
#pragma unroll
                for (int m = 0; m < 4; ++m) { const int row = row0 + ai * 128 + m * 16;
                    const float* bp = row < MP ? baseP + (size_t)row * D : baseS + (size_t)(row - MP) * D; float* op = out + (size_t)row * D;
#pragma unroll
                    for (int bj = 0; bj < 2; ++bj)
#pragma unroll
                        for (int n = 0; n < 2; ++n) { const int c = col0 + bj * 128 + n * 16; const f32x4 b = *(const f32x4*)(bp + c); if (!dry) *(f32x4*)(op + c) = b + acc[ai][bj][m][n]; } }
        } else if constexpr (MODE == EP_SWIGLU) {
            const int col = u.pn * 128 + wc * 32 + 8 * fq;
#pragma unroll
            for (int ai = 0; ai < 2; ++ai)
#pragma unroll
                for (int m = 0; m < 4; ++m) { const int row = row0 + ai * 128 + m * 16; float o[8];
#pragma unroll
                    for (int n = 0; n < 2; ++n)
#pragma unroll
                        for (int e = 0; e < 4; ++e) o[4 * n + e] = siluf(acc[ai][0][m][n][e]) * acc[ai][1][m][n][e];
                    *(u32x4*)(O + (size_t)row * ldo + col) = pack8(o); }
        } else if constexpr (MODE == EP_RW1) {
            const int cw0 = wc * 32 + 8 * fq;
            if (u.pn < 12) { bf16_t* dst = O + (size_t)(u.pn >> 2) * ((WS_K - WS_R) / 2) + (u.pn & 3) * 256 + cw0;
#pragma unroll
                for (int ai = 0; ai < 2; ++ai)
#pragma unroll
                    for (int m = 0; m < 4; ++m)
#pragma unroll
                        for (int bj = 0; bj < 2; ++bj) { u32x4 pk; pk.x = pk2(acc[ai][bj][m][0][0], acc[ai][bj][m][0][1]); pk.y = pk2(acc[ai][bj][m][0][2], acc[ai][bj][m][0][3]);
                            pk.z = pk2(acc[ai][bj][m][1][0], acc[ai][bj][m][1][1]); pk.w = pk2(acc[ai][bj][m][1][2], acc[ai][bj][m][1][3]);
                            *(u32x4*)(dst + (size_t)(row0 + ai * 128 + m * 16) * D + bj * 128) = pk; }
            } else if (u.pn == 12) { const bool th = cw0 < 64;
#pragma unroll
                for (int ai = 0; ai < 2; ++ai)
#pragma unroll
                    for (int m = 0; m < 4; ++m) { float o[8];
#pragma unroll
                        for (int n = 0; n < 2; ++n)
#pragma unroll
                            for (int e = 0; e < 4; ++e) { const float v = acc[ai][0][m][n][e]; o[4 * n + e] = th ? tanh_f(v) : v; }
                        *(u32x4*)(O4 + (size_t)(row0 + ai * 128 + m * 16) * 128 + cw0) = pack8(o); }
            } else {
#pragma unroll
                for (int ai = 0; ai < 2; ++ai)
#pragma unroll
                    for (int m = 0; m < 4; ++m)
#pragma unroll
                        for (int bj = 0; bj < 2; ++bj) { float o[8];
#pragma unroll
                            for (int n = 0; n < 2; ++n)
#pragma unroll
                                for (int e = 0; e < 4; ++e) o[4 * n + e] = sigm(acc[ai][bj][m][n][e]);
                            *(u32x4*)(O5 + (size_t)(row0 + ai * 128 + m * 16) * 256 + bj * 128 + cw0) = pack8(o); }
            }
        } else if constexpr (MODE == EP_RW2) {
            const int c0 = (u.pn & 3) * 256 + wc * 32 + 8 * fq; const bool isw = u.pn < 4; const float* bias = isw ? v0 : v1; bf16_t* dst = O + (isw ? (size_t)0 : (WS_AA - WS_LD) / 2);
#pragma unroll
            for (int bj = 0; bj < 2; ++bj) { const f32x4 b0 = *(const f32x4*)(bias + c0 + bj * 128), b1 = *(const f32x4*)(bias + c0 + bj * 128 + 4);
                if (isw) {
#pragma unroll
                    for (int ai = 0; ai < 2; ++ai)
#pragma unroll
                        for (int m = 0; m < 4; ++m) { float o[8];
#pragma unroll
                            for (int e = 0; e < 4; ++e) { o[e] = -0.6065306597f * sigm(b0[e] + acc[ai][bj][m][0][e]); o[4 + e] = -0.6065306597f * sigm(b1[e] + acc[ai][bj][m][1][e]); }
                            *(u32x4*)(dst + (size_t)(row0 + ai * 128 + m * 16) * D + c0 + bj * 128) = pack8(o); asm volatile("" ::: "memory"); }
                } else {
#pragma unroll
                    for (int ai = 0; ai < 2; ++ai)
#pragma unroll
                        for (int m = 0; m < 4; ++m) { float o[8];
#pragma unroll
                            for (int e = 0; e < 4; ++e) { o[e] = sigm(b0[e] + acc[ai][bj][m][0][e]); o[4 + e] = sigm(b1[e] + acc[ai][bj][m][1][e]); }
                            *(u32x4*)(dst + (size_t)(row0 + ai * 128 + m * 16) * D + c0 + bj * 128) = pack8(o); asm volatile("" ::: "memory"); }
                } }
        } else {
#pragma unroll
            for (int ai = 0; ai < 2; ++ai)
#pragma unroll
                for (int m = 0; m < 4; ++m) { const int row = row0 + ai * 128 + m * 16;
#pragma unroll
                    for (int bj = 0; bj < 2; ++bj) { const int cw = bj * 128 + wc * 32 + 8 * fq; const int col = u.pn * 256 + cw; float o[8];
#pragma unroll
                        for (int n = 0; n < 2; ++n)
#pragma unroll
                            for (int e = 0; e < 4; ++e) o[4 * n + e] = acc[ai][bj][m][n][e];
                        if constexpr (MODE == EP_BF16) { *(u32x4*)(O + (size_t)row * ldo + col) = pack8(o); }
                        else if constexpr (MODE == EP_GLU) { float y[8]; unpack8(*(const u32x4*)(X + (size_t)row * ldx + col), y);
#pragma unroll
                            for (int e = 0; e < 8; ++e) o[e] = y[e] * sigm(o[e]);
                            *(u32x4*)(O + (size_t)row * ldo + col) = pack8(o); }
                        else if constexpr (MODE == EP_GATE) { bf16_t* p = O + (size_t)row * ldo + col; float y[8]; unpack8(*(const u32x4*)p, y);
#pragma unroll
                            for (int e = 0; e < 8; ++e) o[e] *= y[e];
                            if (!dry) *(u32x4*)p = pack8(o); }
                    } }
        }
    }
};

struct Args { const float* in[47]; float* out; unsigned char* ws; };
struct Ctx {
    const float* const* in; float* out; unsigned char* ws; LAS unsigned char* lds;
    int tid, lane, wave, G, blk;
};
enum { I_XP = 0, I_XS, I_S5RE, I_S5IM, I_GDN, I_CONV, I_RWKV, I_SHIFT, I_NMIX, I_NFFN, I_NFIN, I_WG, I_WU, I_WD, I_WIN, I_WOUT, I_LRE, I_LIM, I_LSTEP, I_BRE, I_BIM, I_CRE, I_CIM,
       I_S5D, I_WGLU, I_CONVW, I_ALOG, I_DTB, I_GNW, I_MAA, I_WR, I_WK, I_WV, I_WO, I_W0, I_W1, I_W2, I_A0, I_A1, I_A2, I_G1, I_G2, I_KK, I_KA, I_RK, I_LNW, I_LNB };

struct TJ { int in_idx, in_off, K, N; unsigned dst_off; int ldt, kofs, row_off, ilv, ksmode, ks_row, nitems; };
constexpr TJ mk_tj(int in_idx, int in_off, int K, int N, size_t dst, int ldt, int kofs, int row_off, int ilv, int ksmode, int ks_row) {
    return TJ{in_idx, in_off, K, N, (unsigned)dst, ldt, kofs, row_off, ilv, ksmode, ks_row, ((N + 31) / 32) * ((K + 63) / 64)}; }
constexpr int NTJ = 25;
__constant__ TJ g_tj[NTJ] = {
    mk_tj(14, 0, 1024, 2568, WS_W_IN, 1024, 0, 0, 0, 0, 0), mk_tj(24, 0, 512, 512, WS_W_GLU, 512, 0, 0, 0, 0, 0), mk_tj(15, 0, 1024, 1024, WS_W_OUT, 1024, 0, 0, 0, 0, 0),
    mk_tj(11, 0, 1024, 2816, WS_W_GU0, 1024, 0, 0, 1, 0, 0), mk_tj(12, 0, 1024, 2816, WS_W_GU0, 1024, 0, 128, 1, 0, 0), mk_tj(13, 0, 2816, 1024, WS_W_DN0, 2816, 0, 0, 0, 0, 0),
    mk_tj(11, 1024 * 2816, 1024, 2816, WS_W_GU1, 1024, 0, 0, 1, 0, 0), mk_tj(12, 1024 * 2816, 1024, 2816, WS_W_GU1, 1024, 0, 128, 1, 0, 0), mk_tj(13, 2816 * 1024, 2816, 1024, WS_W_DN1, 2816, 0, 0, 0, 0, 0),
    mk_tj(30, 0, 1024, 1024, WS_W_RW1, 2048, 0, 0, 0, 1, 0), mk_tj(31, 0, 1024, 1024, WS_W_RW1, 2048, 0, 1024, 0, 1, 2), mk_tj(32, 0, 1024, 1024, WS_W_RW1, 2048, 0, 2048, 0, 1, 3),
    mk_tj(35, 0, 1024, 64, WS_W_RW1, 2048, 0, 3072, 0, 1, 1), mk_tj(38, 0, 1024, 64, WS_W_RW1, 2048, 0, 3136, 0, 1, 4), mk_tj(40, 0, 1024, 160, WS_W_RW1, 2048, 0, 3328, 0, 1, 5),
    mk_tj(30, 0, 1024, 1024, WS_W_RW1, 2048, 1024, 0, 0, 2, 0), mk_tj(31, 0, 1024, 1024, WS_W_RW1, 2048, 1024, 1024, 0, 2, 2), mk_tj(32, 0, 1024, 1024, WS_W_RW1, 2048, 1024, 2048, 0, 2, 3),
    mk_tj(35, 0, 1024, 64, WS_W_RW1, 2048, 1024, 3072, 0, 2, 1), mk_tj(38, 0, 1024, 64, WS_W_RW1, 2048, 1024, 3136, 0, 2, 4), mk_tj(40, 0, 1024, 160, WS_W_RW1, 2048, 1024, 3328, 0, 2, 5),
    mk_tj(36, 0, 64, 1024, WS_W_RW2, 128, 0, 0, 0, 0, 0), mk_tj(39, 0, 64, 1024, WS_W_RW2, 128, 64, 1024, 0, 0, 0), mk_tj(41, 0, 160, 1024, WS_W_G2, 256, 0, 0, 0, 0, 0),
    mk_tj(33, 0, 1024, 1024, WS_W_O, 1024, 0, 0, 0, 0, 0) };
DI void tr_all(const Ctx& C, int j0, int j1, int b0) {
    LAS float* scr = (LAS float*)(C.lds + C.wave * 16384);
    const int lane = opaque_tid() & 63, gw = (C.blk - b0) * 8 + C.wave, NGW = (C.G - b0) * 8;
    int total = 0;
    for (int j = j0; j < j1; ++j) total += g_tj[j].nitems;
    for (int it0 = gw; it0 < total; it0 += NGW) {
        int it = __builtin_amdgcn_readfirstlane(it0), j = j0;
        while (it >= g_tj[j].nitems) { it -= g_tj[j].nitems; ++j; }
        const TJ J = g_tj[j];
        const float* W = C.in[J.in_idx] + J.in_off; const float* ks = C.in[I_MAA] + J.ks_row * 1024; bf16_t* WT = (bf16_t*)(C.ws + J.dst_off);
        const int K = J.K, N = J.N, nblk = (N + 31) / 32;
        const int kb = it / nblk, nb = it - kb * nblk, k0 = 64 * kb, n0 = 32 * nb;
        const int nn = n0 + (lane & 31); float v[32];
#pragma unroll
        for (int i = 0; i < 32; ++i) { const int k = k0 + 2 * i + (lane >> 5); v[i] = (k < K && nn < N) ? W[(size_t)k * N + nn] : 0.f; }
        if (J.ksmode) {
#pragma unroll
            for (int i = 0; i < 32; ++i) { const int k = k0 + 2 * i + (lane >> 5); const float s = (k < K) ? ks[k] : 0.f; v[i] *= (J.ksmode == 1) ? (1.f - s) : s; } }
#pragma unroll
        for (int i = 0; i < 32; ++i) scr[(2 * i + (lane >> 5)) * 33 + (lane & 31)] = v[i];
        LDS_WAIT();
        const int c = lane & 7;
#pragma unroll
        for (int jj = 0; jj < 4; ++jj) { const int n = (lane >> 3) + 8 * jj; const LAS float* s = scr + (8 * c) * 33 + n;
            u32x4 o; o.x = pk2(s[0 * 33], s[1 * 33]); o.y = pk2(s[2 * 33], s[3 * 33]); o.z = pk2(s[4 * 33], s[5 * 33]); o.w = pk2(s[6 * 33], s[7 * 33]);
            const int ng = n0 + n;
            if (ng < N) { const int dr = J.row_off + (J.ilv ? ((ng >> 7) * 256 + (ng & 127)) : ng); *(u32x4*)(WT + (size_t)dr * J.ldt + J.kofs + k0 + 8 * c) = o; } }
        LDS_WAIT();
    }
}
DI void zero_rect(const Ctx& C, bf16_t* P, int ld, int row0, int nrows, int col0, int ncols, int b0 = 0) {
    const int cpr = ncols / 8, total = nrows * cpr;
    for (int e = (C.blk - b0) * 512 + opaque_tid(); e < total; e += (C.G - b0) * 512) { const int r = e / cpr, c = e % cpr; *(u32x4*)(P + (size_t)(row0 + r) * ld + col0 + 8 * c) = (u32x4){0u, 0u, 0u, 0u}; }
}

template <int MODE> DI void rms_rows(const Ctx& C, const float* srcP, const float* srcS, const float* w, bf16_t* dst, const float* part = nullptr, int nslice = 0, const float* baseS = nullptr) {
    const int gw = C.blk * 8 + C.wave, NGW = C.G * 8, lane = opaque_tid() & 63;
    f32x4 wv[4];
#pragma unroll
    for (int j = 0; j < 4; ++j) wv[j] = *(const f32x4*)(w + 4 * lane + 256 * j);
    for (int m = gw; m < M; m += NGW) {
        const float* xr = m < MP ? srcP + (size_t)m * D : srcS + (size_t)(m - MP) * D;
        f32x4 v[4]; float s = 0.f;
#pragma unroll
        for (int j = 0; j < 4; ++j) v[j] = *(const f32x4*)(xr + 4 * lane + 256 * j);
        if (part && m >= MP) { const float* bs = baseS + (size_t)(m - MP) * D;
#pragma unroll
            for (int j = 0; j < 4; ++j) v[j] = *(const f32x4*)(bs + 4 * lane + 256 * j);
            for (int sl = 0; sl < nslice; ++sl) { const float* pp = part + ((size_t)sl * MS + (size_t)(m - MP)) * D;
#pragma unroll
                for (int j = 0; j < 4; ++j) v[j] += *(const f32x4*)(pp + 4 * lane + 256 * j); }
            if constexpr (MODE != 2) { float* xw = const_cast<float*>(xr);
#pragma unroll
                for (int j = 0; j < 4; ++j) *(f32x4*)(xw + 4 * lane + 256 * j) = v[j]; } }
#pragma unroll
        for (int j = 0; j < 4; ++j) s += (v[j].x * v[j].x + v[j].y * v[j].y) + (v[j].z * v[j].z + v[j].w * v[j].w);
        const float rstd = __builtin_amdgcn_rsqf(wave_sum(s) * (1.f / D) + NORM_EPS);
#pragma unroll
        for (int j = 0; j < 4; ++j) v[j] = v[j] * rstd * wv[j];
        if constexpr (MODE == 2) {
            float* o = C.out + (size_t)m * D;
#pragma unroll
            for (int j = 0; j < 4; ++j) *(f32x4*)(o + 4 * lane + 256 * j) = v[j];
        } else {
            u32x2 pk[4];
#pragma unroll
            for (int j = 0; j < 4; ++j) { pk[j].x = pk2(v[j].x, v[j].y); pk[j].y = pk2(v[j].z, v[j].w); }
            if constexpr (MODE == 0) {
#pragma unroll
                for (int j = 0; j < 4; ++j) *(u32x2*)(dst + (size_t)m * D + 4 * lane + 256 * j) = pk[j];
            } else {
                const bool prompt = m < MP; const int pos = prompt ? (m & (SEQP - 1)) : ((m - MP) & (SEQS - 1)); const int len = prompt ? SEQP : SEQS;
                const int b = prompt ? (m >> 11) : ((m - MP) >> 3);
#pragma unroll
                for (int j = 0; j < 4; ++j) *(u32x2*)(dst + (size_t)m * 2048 + 4 * lane + 256 * j) = pk[j];
                if (pos + 1 < len) {
#pragma unroll
                    for (int j = 0; j < 4; ++j) *(u32x2*)(dst + (size_t)(m + 1) * 2048 + 1024 + 4 * lane + 256 * j) = pk[j];
                } else {
                    float* so = C.out + (prompt ? O_P_SHIFT : O_S_SHIFT) + (size_t)b * D;
#pragma unroll
                    for (int j = 0; j < 4; ++j) *(f32x4*)(so + 4 * lane + 256 * j) = v[j];
                }
                if (pos == 0) {
#pragma unroll
                    for (int j = 0; j < 4; ++j) { u32x2 z = {0u, 0u};
                        if (!prompt) { const f32x4 sv = *(const f32x4*)(C.in[I_SHIFT] + (size_t)b * D + 4 * lane + 256 * j); z.x = pk2(sv.x, sv.y); z.y = pk2(sv.z, sv.w); }
                        *(u32x2*)(dst + (size_t)m * 2048 + 1024 + 4 * lane + 256 * j) = z; }
                }
            }
        }
    }
}

constexpr size_t WS_S5E = 0, WS_YG = 239 * MiB;
constexpr int S5SEG = 256;
static_assert(WS_YG + (size_t)M * 512 * 2 <= WS_END && 222 * MiB + (size_t)M * 512 * 2 <= WS_YG, "yg");
template <int MODE> DI void s5_unit(const Ctx& C, int seq, int g, int seg) {
    const int lane = opaque_tid() & 63, p = lane, r = lane & 15, q = lane >> 4;
    LAS unsigned char* wl = C.lds + C.wave * 16384;
    const bool prompt = seq < NBP; const int b = prompt ? seq : seq - NBP; const int start = prompt ? seq * SEQP + seg * S5SEG : MP + b * SEQS; const int len = prompt ? S5SEG : SEQS;
    const bf16_t* PROJ = (const bf16_t*)(C.ws + WS_PROJ); bf16_t* YG = (bf16_t*)(C.ws + WS_YG);
    float* E = (float*)(C.ws + WS_S5E);
    float abr, abi;
    bf16x8 Bf[8], Cf[4]; float dsk[4];
    {
        const float lr = C.in[I_LRE][g * 64 + p], li = C.in[I_LIM][g * 64 + p], dt = expf(C.in[I_LSTEP][g]);
        const float mag = expf(lr * dt); abr = mag * cosf(li * dt); abi = mag * sinf(li * dt);
        const float den = lr * lr + li * li, nr = abr - 1.f, ni = abi, cr = (nr * lr + ni * li) / den, ci = (ni * lr - nr * li) / den;
        LAS bf16_t* BB = (LAS bf16_t*)wl;
        const float* bre = C.in[I_BRE] + (size_t)(g * 64 + p) * 16; const float* bim = C.in[I_BIM] + (size_t)(g * 64 + p) * 16;
#pragma unroll
        for (int c = 0; c < 16; c += 2) { const float r0 = bre[c], i0 = bim[c], r1 = bre[c + 1], i1 = bim[c + 1];
            *(LAS unsigned*)(BB + p * 16 + c) = pk2(cr * r0 - ci * i0, cr * r1 - ci * i1);
            *(LAS unsigned*)(BB + (64 + p) * 16 + c) = pk2(cr * i0 + ci * r0, cr * i1 + ci * r1); }
        LDS_WAIT();
#pragma unroll
        for (int nb = 0; nb < 8; ++nb) { bf16x8 z = {0, 0, 0, 0, 0, 0, 0, 0}; if (q < 2) z = *(const LAS bf16x8*)(BB + (16 * nb + r) * 16 + 8 * q); Bf[nb] = z; }
        LDS_WAIT();
        if constexpr (MODE == 2) {
#pragma unroll
            for (int kk = 0; kk < 4; ++kk) { const float* src = (kk < 2 ? C.in[I_CRE] : C.in[I_CIM]) + (size_t)(g * 16 + r) * 64 + 32 * (kk & 1) + 8 * q; const float sg = kk < 2 ? 1.f : -1.f;
                float x[8];
#pragma unroll
                for (int e = 0; e < 8; ++e) x[e] = sg * src[e];
                Cf[kk] = __builtin_bit_cast(bf16x8, pack8(x)); }
#pragma unroll
            for (int i = 0; i < 4; ++i) dsk[i] = C.in[I_S5D][g * 16 + 4 * q + i];
        }
    }
    float xr = 0.f, xi = 0.f;
    if constexpr (MODE == 2) {
        if (!prompt) { xr = C.in[I_S5RE][(size_t)(b * 32 + g) * 64 + p]; xi = C.in[I_S5IM][(size_t)(b * 32 + g) * 64 + p]; }
        else if (seg > 0) {
            float pr = abr, pi = abi;
#pragma unroll
            for (int i = 0; i < 8; ++i) { const float nr2 = pr * pr - pi * pi, ni2 = 2.f * pr * pi; pr = nr2; pi = ni2; }
            const float* e0 = E + ((size_t)(seq * 32 + g) * 8) * 128 + p;
            for (int s = 0; s < seg; ++s) { const float er = e0[s * 128], ei = e0[s * 128 + 64]; const float nxr = pr * xr - pi * xi + er, nxi = pr * xi + pi * xr + ei; xr = nxr; xi = nxi; }
        }
    }
    LAS float* XT = (LAS float*)wl;
    bf16x8 UfN = {0, 0, 0, 0, 0, 0, 0, 0}; u32x2 udN = {0u, 0u};
    { int mr = start + r; if (mr > M - 1) mr = M - 1;
      if (q < 2) UfN = *(const bf16x8*)(PROJ + (size_t)mr * NPROJ + 16 * g + 8 * q);
      if constexpr (MODE == 2) udN = *(const u32x2*)(PROJ + (size_t)mr * NPROJ + 16 * g + 4 * q); }
    for (int t0 = 0; t0 < len; t0 += 16) {
        const int nt = (len - t0) < 16 ? (len - t0) : 16; const int m0 = start + t0;
        const bf16x8 Uf = UfN; const u32x2 ud = udN;
        if (t0 + 16 < len) { int mr = m0 + 16 + r; if (mr > M - 1) mr = M - 1;
            if (q < 2) UfN = *(const bf16x8*)(PROJ + (size_t)mr * NPROJ + 16 * g + 8 * q);
            if constexpr (MODE == 2) udN = *(const u32x2*)(PROJ + (size_t)mr * NPROJ + 16 * g + 4 * q); }
#pragma unroll
        for (int nb = 0; nb < 8; ++nb) { f32x4 a = {0.f, 0.f, 0.f, 0.f}; a = MFMA16(Bf[nb], Uf, a); *(LAS f32x4*)(XT + r * 132 + 16 * nb + 4 * q) = a; }
        LDS_WAIT();
        for (int tl = 0; tl < nt; ++tl) {
            const float bur = XT[tl * 132 + p], bui = XT[tl * 132 + 64 + p];
            const float nxr = abr * xr - abi * xi + bur, nxi = abr * xi + abi * xr + bui;
            xr = nxr; xi = nxi;
            if constexpr (MODE == 2) { XT[tl * 132 + p] = xr; XT[tl * 132 + 64 + p] = xi; }
        }
        LDS_WAIT();
        if constexpr (MODE == 2) {
            f32x4 y = {0.f, 0.f, 0.f, 0.f};
#pragma unroll
            for (int kk = 0; kk < 4; ++kk) { const f32x4 a0 = *(const LAS f32x4*)(XT + r * 132 + 32 * kk + 8 * q), a1 = *(const LAS f32x4*)(XT + r * 132 + 32 * kk + 8 * q + 4);
                u32x4 w; w.x = pk2(a0.x, a0.y); w.y = pk2(a0.z, a0.w); w.z = pk2(a1.x, a1.y); w.w = pk2(a1.z, a1.w);
                y = MFMA16(Cf[kk], __builtin_bit_cast(bf16x8, w), y); }
            const float u0 = bf_lo(ud.x), u1 = bf_hi(ud.x), u2 = bf_lo(ud.y), u3 = bf_hi(ud.y);
            const float g0 = gelu_t(y[0] + dsk[0] * u0), g1 = gelu_t(y[1] + dsk[1] * u1), g2 = gelu_t(y[2] + dsk[2] * u2), g3 = gelu_t(y[3] + dsk[3] * u3);
            if (r < nt) { u32x2 o; o.x = pk2(g0, g1); o.y = pk2(g2, g3); *(u32x2*)(YG + (size_t)(m0 + r) * 512 + 16 * g + 4 * q) = o; }
            LDS_WAIT();
        }
    }
    if constexpr (MODE == 1) { float* e0 = E + ((size_t)(seq * 32 + g) * 8 + seg) * 128 + p; e0[0] = xr; e0[64] = xi; }
    else if (!prompt || seg == 7) {
        float* ore = C.out + (prompt ? O_P_S5RE : O_S_S5RE) + (size_t)(b * 32 + g) * 64 + p; float* oim = C.out + (prompt ? O_P_S5IM : O_S_S5IM) + (size_t)(b * 32 + g) * 64 + p;
        *ore = xr; *oim = xi; }
}

constexpr size_t GDN_FR_BYTES = 57344 + 256;
constexpr size_t WS_UG = WS_HB;
constexpr size_t WS_OB = 222 * MiB;
static_assert(WS_OB + (size_t)M * 512 * 2 <= WS_END && (size_t)1024 * 32768 <= 34 * MiB && (size_t)1024 * GDN_FR_BYTES <= (size_t)M * D * 4, "gdn scratch");

DI void gdn_state_step(LAS unsigned char* fb, f32x4 (&Sacc)[8], const f32x4 (&Uacc)[4], bf16_t* OBrow  , int ntok, int lane, int w) {
    const int r = lane & 15, q = lane >> 4;
    const LAS float* gcV = (const LAS float*)(fb + 57344);
#define FRAG(f) (*(const LAS bf16x8*)(fb + (f) * 1024 + lane * 16))
    bf16x8 Sf[4];
#pragma unroll
    for (int kk = 0; kk < 4; ++kk) { u32x4 p; p.x = pk2(Sacc[2 * kk][0], Sacc[2 * kk][1]); p.y = pk2(Sacc[2 * kk][2], Sacc[2 * kk][3]); p.z = pk2(Sacc[2 * kk + 1][0], Sacc[2 * kk + 1][1]); p.w = pk2(Sacc[2 * kk + 1][2], Sacc[2 * kk + 1][3]);
        Sf[kk] = __builtin_bit_cast(bf16x8, p); }
    const float glast = gcV[63];
    f32x4 vn[4], oacc[4];
#pragma unroll
    for (int tb = 0; tb < 4; ++tb) { f32x4 ws = {0.f, 0.f, 0.f, 0.f}, qs = {0.f, 0.f, 0.f, 0.f};
#pragma unroll
        for (int kk = 0; kk < 4; ++kk) { ws = MFMA16(FRAG(tb * 4 + kk), Sf[kk], ws); qs = MFMA16(FRAG(16 + tb * 4 + kk), Sf[kk], qs); }
        vn[tb] = Uacc[tb] - ws;
        const f32x4 g4 = *(const LAS f32x4*)(gcV + 16 * tb + 4 * q);
#pragma unroll
        for (int i = 0; i < 4; ++i) qs[i] *= __expf(g4[i]);
        oacc[tb] = qs; }
    bf16x8 Vf[2], Vsf[2];
#pragma unroll
    for (int k2 = 0; k2 < 2; ++k2) { u32x4 p, ps; const f32x4 g0 = *(const LAS f32x4*)(gcV + 32 * k2 + 4 * q), g1 = *(const LAS f32x4*)(gcV + 32 * k2 + 16 + 4 * q); float sc0[4], sc1[4];
#pragma unroll
        for (int i = 0; i < 4; ++i) { sc0[i] = __expf(glast - g0[i]); sc1[i] = __expf(glast - g1[i]); }
        const f32x4 v0 = vn[2 * k2], v1 = vn[2 * k2 + 1];
        p.x = pk2(v0[0], v0[1]); p.y = pk2(v0[2], v0[3]); p.z = pk2(v1[0], v1[1]); p.w = pk2(v1[2], v1[3]);
        ps.x = pk2(v0[0] * sc0[0], v0[1] * sc0[1]); ps.y = pk2(v0[2] * sc0[2], v0[3] * sc0[3]); ps.z = pk2(v1[0] * sc1[0], v1[1] * sc1[1]); ps.w = pk2(v1[2] * sc1[2], v1[3] * sc1[3]);
        Vf[k2] = __builtin_bit_cast(bf16x8, p); Vsf[k2] = __builtin_bit_cast(bf16x8, ps); }
#pragma unroll
    for (int tb = 0; tb < 4; ++tb)
#pragma unroll
        for (int k2 = 0; k2 < 2; ++k2) oacc[tb] = MFMA16(FRAG(32 + tb * 2 + k2), Vf[k2], oacc[tb]);
    { const float eg = __expf(glast);
#pragma unroll
      for (int kb = 0; kb < 8; ++kb) { f32x4 s = Sacc[kb] * eg;
#pragma unroll
        for (int k2 = 0; k2 < 2; ++k2) s = MFMA16(FRAG(40 + kb * 2 + k2), Vsf[k2], s);
        Sacc[kb] = s; } }
#undef FRAG
#pragma unroll
    for (int tb = 0; tb < 4; ++tb)
#pragma unroll
        for (int i = 0; i < 4; ++i) { const int t = 16 * tb + 4 * q + i; if (t < ntok) OBrow[(size_t)t * 512 + 16 * w + r] = f2bf(oacc[tb][i]); }
}

DI void gdn_unit(const Ctx& C, int seq, int t0, int h) {
    const int tid = opaque_tid(), lane = tid & 63, w = C.wave, r = lane & 15, q = lane >> 4;
    const bool prompt = seq < NBP; const int b = prompt ? seq : seq - NBP; const int start = prompt ? seq * SEQP : MP + b * SEQS; const int len = prompt ? SEQP : SEQS;
    const bf16_t* PROJ = (const bf16_t*)(C.ws + WS_PROJ);
    LAS unsigned char* L = C.lds;
    LAS bf16_t* Kn = (LAS bf16_t*)(L + 0);
    LAS bf16_t* Qn = (LAS bf16_t*)(L + 17408);
    LAS bf16_t* Knt = (LAS bf16_t*)(L + 34816);
    LAS bf16_t* Vt = (LAS bf16_t*)(L + 53248);
    LAS float* Lm = (LAS float*)(L + 71680);
    LAS bf16_t* Wl = (LAS bf16_t*)(L + 71680);
    LAS float* Tm = (LAS float*)(L + 89088);
    LAS bf16_t* Tp = (LAS bf16_t*)(L + 105728);
    LAS bf16_t* Tpp = (LAS bf16_t*)(L + 114944);
    LAS bf16_t* Aqk = (LAS bf16_t*)(L + 124160);
    LAS float* Pb = (LAS float*)(L + 133376);
    LAS float* betaV = (LAS float*)(L + 136640);
    LAS float* gcV = betaV + 64;
    const int ntok = (len - t0) < 64 ? (len - t0) : 64;
    if (tid < 384) {
        const int tg = tid / 48, combo = tid - 48 * tg, ty = combo >> 4, cgp = combo & 15; const int cc = ty * 512 + h * 128 + 8 * cgp;
        u32x4 raw[11]; float xs[3][8];
#pragma unroll
        for (int j = 0; j < 3; ++j)
#pragma unroll
            for (int e = 0; e < 8; ++e) xs[j][e] = 0.f;
#pragma unroll
        for (int j = 0; j < 11; ++j) { const int tt = t0 + 8 * tg - 3 + j; raw[j] = (u32x4){0u, 0u, 0u, 0u};
            if (tt >= 0 && tt < len) raw[j] = *(const u32x4*)(PROJ + (size_t)(start + tt) * NPROJ + 512 + cc); }
        const bool head = (t0 + 8 * tg) < 3;
        if (head && !prompt) {
#pragma unroll
            for (int j = 0; j < 3; ++j) { const float* cs = C.in[I_CONV] + (size_t)(b * 3 + j) * 1536 + cc;
#pragma unroll
                for (int e = 0; e < 8; ++e) xs[j][e] = cs[e]; } }
        f32x4 cw[4][2];
#pragma unroll
        for (int j = 0; j < 4; ++j) { cw[j][0] = *(const f32x4*)(C.in[I_CONVW] + (size_t)j * 1536 + cc); cw[j][1] = *(const f32x4*)(C.in[I_CONVW] + (size_t)j * 1536 + cc + 4); }
        float out[8][8];
#pragma unroll
        for (int s = 0; s < 8; ++s) { float a[8];
#pragma unroll
            for (int e = 0; e < 8; ++e) a[e] = 0.f;
#pragma unroll
            for (int j = 0; j < 4; ++j) { float xv[8]; unpack8(raw[s + j], xv);
                if (s + j < 3) { if (head) {
#pragma unroll
                        for (int e = 0; e < 8; ++e) xv[e] = xs[s + j][e]; } }
#pragma unroll
                for (int e = 0; e < 8; ++e) a[e] += xv[e] * cw[j][e >> 2][e & 3]; }
            const bool valid = (8 * tg + s) < ntok; float ss = 0.f;
#pragma unroll
            for (int e = 0; e < 8; ++e) { a[e] = valid ? siluf(a[e]) : 0.f; ss += a[e] * a[e]; }
            ss = sum16(ss);
            const float rs = (ty < 2) ? (__builtin_amdgcn_rsqf(ss + NORM_EPS)) * (ty == 0 ? 0.08838834764831845f : 1.f) : 1.f;
#pragma unroll
            for (int e = 0; e < 8; ++e) out[s][e] = a[e] * rs; }
        if (ty < 2) { LAS bf16_t* dst = (ty == 0 ? Qn : Kn) + (8 * tg) * 136 + 8 * cgp;
#pragma unroll
            for (int s = 0; s < 8; ++s) *(LAS u32x4*)(dst + s * 136) = pack8(out[s]); }
        if (ty >= 1) { LAS bf16_t* dst = (ty == 1 ? Knt : Vt) + (8 * cgp) * 72 + 8 * tg;
#pragma unroll
            for (int e = 0; e < 8; ++e) { u32x4 pk; pk.x = pk2(out[0][e], out[1][e]); pk.y = pk2(out[2][e], out[3][e]); pk.z = pk2(out[4][e], out[5][e]); pk.w = pk2(out[6][e], out[7][e]);
                *(LAS u32x4*)(dst + e * 72) = pk; } }
    } else if (w == 6) { const int t = lane; float bt = 0.f, gg = 0.f;
        if (t < ntok) { const size_t mrow = (size_t)(start + t0 + t) * NPROJ; bt = sigm(bf1(PROJ[mrow + 2048 + h])); gg = -expf(C.in[I_ALOG][h]) * softplusf(bf1(PROJ[mrow + 2052 + h]) + C.in[I_DTB][h]); }
        float s = gg;
#pragma unroll
        for (int o = 1; o < 64; o <<= 1) { const float v = __shfl_up(s, o); if (lane >= o) s += v; }
        betaV[t] = bt; gcV[t] = s; }
    LBAR();
#pragma unroll 1
    for (int b4 = 0; b4 < 4; ++b4) { const int idx = 4 * w + b4; const bool isq = idx >= 16; const int id = idx & 15, bi = id >> 2, bj = id & 3;
        const LAS bf16_t* Asrc = isq ? Qn : Kn; f32x4 a = {0.f, 0.f, 0.f, 0.f};
#pragma unroll
        for (int kk = 0; kk < 4; ++kk) a = MFMA16(*(const LAS bf16x8*)(Asrc + (16 * bi + r) * 136 + 32 * kk + 8 * q), *(const LAS bf16x8*)(Kn + (16 * bj + r) * 136 + 32 * kk + 8 * q), a);
        const int j = 16 * bj + r; const float gj = gcV[j];
#pragma unroll
        for (int ii = 0; ii < 4; ++ii) { const int i = 16 * bi + 4 * q + ii; const float e = (i >= j) ? __expf(gcV[i] - gj) : 0.f;
            if (!isq) Lm[i * 65 + j] = (i > j) ? betaV[i] * a[ii] * e : 0.f;
            else Aqk[i * 72 + j] = f2bf(a[ii] * e); } }
    LBAR();
    if (tid < 64) { const int bb = tid >> 4, c = tid & 15; float t[16];
#pragma unroll
        for (int i = 0; i < 16; ++i) { float s = (i == c) ? 1.f : 0.f;
#pragma unroll
            for (int j = 0; j < i; ++j) s -= Lm[(16 * bb + i) * 65 + 16 * bb + j] * t[j];
            t[i] = s; Tm[(16 * bb + i) * 65 + 16 * bb + c] = s; } }
    LBAR();
    if (ntok <= 16) {
        for (int it = tid; it < 6 * 256; it += 512) { const int p = it >> 8, i = (it >> 4) & 15, j = it & 15; const int I = p < 1 ? 1 : (p < 3 ? 2 : 3), J = p - (I == 1 ? 0 : (I == 2 ? 1 : 3));
            Tm[(16 * I + i) * 65 + 16 * J + j] = 0.f; }
        LBAR();
    } else
#pragma unroll 1
    for (int I = 1; I < 4; ++I) {
        for (int it = tid; it < I * 256; it += 512) { const int J = it >> 8, i = (it >> 4) & 15, j = it & 15; float s = 0.f;
            for (int Kb = J; Kb < I; ++Kb)
#pragma unroll
                for (int k = 0; k < 16; ++k) s += Lm[(16 * I + i) * 65 + 16 * Kb + k] * Tm[(16 * Kb + k) * 65 + 16 * J + j];
            Pb[(J * 16 + i) * 17 + j] = s; }
        LBAR();
        for (int it = tid; it < I * 256; it += 512) { const int J = it >> 8, i = (it >> 4) & 15, j = it & 15; float s = 0.f;
#pragma unroll
            for (int k = 0; k < 16; ++k) s += Tm[(16 * I + i) * 65 + 16 * I + k] * Pb[(J * 16 + k) * 17 + j];
            Tm[(16 * I + i) * 65 + 16 * J + j] = -s; }
        LBAR();
    }
    for (int e = tid; e < 4096; e += 512) { const int i = e >> 6, j = e & 63; const float tv = (j <= i) ? Tm[i * 65 + j] : 0.f; const float bj = betaV[j];
        Tp[i * 72 + j] = f2bf(tv * bj * __expf(gcV[j])); Tpp[i * 72 + j] = f2bf(tv * bj); }
    LBAR();
    f32x4 Uacc[4];
#pragma unroll
    for (int tb = 0; tb < 4; ++tb) { f32x4 a = {0.f, 0.f, 0.f, 0.f}, u = {0.f, 0.f, 0.f, 0.f};
#pragma unroll
        for (int kk = 0; kk < 2; ++kk) {
            a = MFMA16(*(const LAS bf16x8*)(Knt + (16 * w + r) * 72 + 32 * kk + 8 * q), *(const LAS bf16x8*)(Tp + (16 * tb + r) * 72 + 32 * kk + 8 * q), a);
            u = MFMA16(*(const LAS bf16x8*)(Tpp + (16 * tb + r) * 72 + 32 * kk + 8 * q), *(const LAS bf16x8*)(Vt + (16 * w + r) * 72 + 32 * kk + 8 * q), u); }
        u32x2 o; o.x = pk2(a[0], a[1]); o.y = pk2(a[2], a[3]); *(LAS u32x2*)(Wl + (16 * tb + r) * 136 + 16 * w + 4 * q) = o;
        Uacc[tb] = u; }
    LBAR();
    u32x4 fr[7];
#pragma unroll
    for (int i = 0; i < 7; ++i) { const int f = 7 * w + i; const LAS bf16_t* src; int rowb, ld, cb;
        if (f < 16) { src = Wl; ld = 136; rowb = 16 * (f >> 2); cb = 32 * (f & 3); }
        else if (f < 32) { src = Qn; ld = 136; rowb = 16 * ((f - 16) >> 2); cb = 32 * (f & 3); }
        else if (f < 40) { src = Aqk; ld = 72; rowb = 16 * ((f - 32) >> 1); cb = 32 * (f & 1); }
        else { src = Knt; ld = 72; rowb = 16 * ((f - 40) >> 1); cb = 32 * (f & 1); }
        const u32x2 a0 = *(const LAS u32x2*)(src + (rowb + r) * ld + cb + 4 * q), a1 = *(const LAS u32x2*)(src + (rowb + r) * ld + cb + 16 + 4 * q);
        fr[i] = (u32x4){a0.x, a0.y, a1.x, a1.y}; }
    const float gcl = (tid < 64) ? gcV[tid] : 0.f;
    if (prompt) {
        const int u = (seq * 32 + (t0 >> 6)) * 4 + h;
        unsigned char* frg = (unsigned char*)C.out + (size_t)u * GDN_FR_BYTES;
#pragma unroll
        for (int i = 0; i < 7; ++i) *(u32x4*)(frg + (size_t)(7 * w + i) * 1024 + lane * 16) = fr[i];
        if (tid < 64) *(float*)(frg + 57344 + tid * 4) = gcl;
        f32x4* ug = (f32x4*)(C.ws + WS_UG + (size_t)u * 32768) + (w * 4) * 64 + lane;
#pragma unroll
        for (int tb = 0; tb < 4; ++tb) ug[tb * 64] = Uacc[tb];
        LBAR();
    } else {
        LBAR();
#pragma unroll
        for (int i = 0; i < 7; ++i) *(LAS u32x4*)(L + (7 * w + i) * 1024 + lane * 16) = fr[i];
        if (tid < 64) *(LAS float*)(L + 57344 + tid * 4) = gcl;
        f32x4 Sacc[8];
        { const float* s0 = C.in[I_GDN] + (size_t)(b * 4 + h) * 16384 + (4 * q) * 128 + 16 * w + r;
#pragma unroll
          for (int kb = 0; kb < 8; ++kb)
#pragma unroll
            for (int i = 0; i < 4; ++i) Sacc[kb][i] = s0[(16 * kb + i) * 128]; }
        LBAR();
        gdn_state_step(L, Sacc, Uacc, (bf16_t*)(C.ws + WS_OB) + (size_t)(start + t0) * 512 + h * 128, ntok, lane, w);
        { int lo = (4 * q) * 128 + 16 * w + r; asm volatile("" : "+v"(lo));
          float* so = C.out + O_S_GDN + (size_t)(b * 4 + h) * 16384 + lo;
#pragma unroll
          for (int kb = 0; kb < 8; ++kb)
#pragma unroll
            for (int i = 0; i < 4; ++i) so[(16 * kb + i) * 128] = Sacc[kb][i]; }
        float* co = C.out + O_S_CONV + (size_t)b * 3 * 1536;
        for (int e = tid; e < 1152; e += 512) { const int j = e / 384, rem = e - 384 * j, ty = rem >> 7, d = rem & 127; const int cc = ty * 512 + h * 128 + d;
            co[j * 1536 + cc] = bf1(PROJ[(size_t)(start + len - 3 + j) * NPROJ + 512 + cc]); }
        LBAR();
    }
}

DI void gdn_seq(const Ctx& C, int seq, int h, int half) {
    const int tid = opaque_tid(), lane = tid & 63, w = 4 * half + (C.wave & 3), r = lane & 15, q = lane >> 4; const bool act = C.wave < 4;
    const int start = seq * SEQP; const bf16_t* PROJ = (const bf16_t*)(C.ws + WS_PROJ);
    LAS unsigned char* L = C.lds; constexpr int BUF = 58368;
    f32x4 Sacc[8];
#pragma unroll
    for (int kb = 0; kb < 8; ++kb) Sacc[kb] = (f32x4){0.f, 0.f, 0.f, 0.f};
    const int u0 = (seq * 32) * 4 + h;
    u32x4 pf[7]; u32x4 pg = {0u, 0u, 0u, 0u}; f32x4 Un[4], Uc[4];
    { const unsigned char* frg = (const unsigned char*)C.out + (size_t)u0 * GDN_FR_BYTES;
#pragma unroll
      for (int i = 0; i < 7; ++i) pf[i] = *(const u32x4*)(frg + (size_t)i * 8192 + tid * 16);
      if (tid < 16) pg = *(const u32x4*)(frg + 57344 + tid * 16);
      const f32x4* ug = (const f32x4*)(C.ws + WS_UG + (size_t)u0 * 32768) + (w * 4) * 64 + lane;
#pragma unroll
      for (int tb = 0; tb < 4; ++tb) Un[tb] = ug[tb * 64];
#pragma unroll
      for (int i = 0; i < 7; ++i) *(LAS u32x4*)(L + i * 8192 + tid * 16) = pf[i];
      if (tid < 16) *(LAS u32x4*)(L + 57344 + tid * 16) = pg; }
#pragma unroll 1
    for (int c = 0; c < 32; ++c) {
        LBAR();
        LAS unsigned char* fb = L + (c & 1) * BUF;
#pragma unroll
        for (int tb = 0; tb < 4; ++tb) Uc[tb] = Un[tb];
        if (c + 1 < 32) { const int u = u0 + (c + 1) * 4; const unsigned char* frg = (const unsigned char*)C.out + (size_t)u * GDN_FR_BYTES;
#pragma unroll
            for (int i = 0; i < 7; ++i) pf[i] = *(const u32x4*)(frg + (size_t)i * 8192 + tid * 16);
            if (tid < 16) pg = *(const u32x4*)(frg + 57344 + tid * 16);
            const f32x4* ug = (const f32x4*)(C.ws + WS_UG + (size_t)u * 32768) + (w * 4) * 64 + lane;
#pragma unroll
            for (int tb = 0; tb < 4; ++tb) Un[tb] = ug[tb * 64]; }
        if (act) gdn_state_step(fb, Sacc, Uc, (bf16_t*)(C.ws + WS_OB) + (size_t)(start + c * 64) * 512 + h * 128, 64, lane, w);
        if (c + 1 < 32) { LAS unsigned char* nb = L + ((c + 1) & 1) * BUF;
#pragma unroll
            for (int i = 0; i < 7; ++i) *(LAS u32x4*)(nb + i * 8192 + tid * 16) = pf[i];
            if (tid < 16) *(LAS u32x4*)(nb + 57344 + tid * 16) = pg; }
    }
    if (act) { int lo = (4 * q) * 128 + 16 * w + r; asm volatile("" : "+v"(lo));
      float* so = C.out + O_P_GDN + (size_t)(seq * 4 + h) * 16384 + lo;
#pragma unroll
      for (int kb = 0; kb < 8; ++kb)
#pragma unroll
        for (int i = 0; i < 4; ++i) so[(16 * kb + i) * 128] = Sacc[kb][i]; }
    float* co = C.out + O_P_CONV + (size_t)seq * 3 * 1536;
    if (half == 0) for (int e = tid; e < 1152; e += 512) { const int j = e / 384, rem = e - 384 * j, ty = rem >> 7, d = rem & 127; const int cc = ty * 512 + h * 128 + d;
        co[j * 1536 + cc] = bf1(PROJ[(size_t)(start + SEQP - 3 + j) * NPROJ + 512 + cc]); }
}

DI void gdn_post(const Ctx& C, int b0, int it0, int it1) {
    const int tid = opaque_tid(), l16 = tid & 15; const int grp = ((C.blk - b0) * 512 + tid) >> 4, ngrp = (C.G - b0) * 32;
    const bf16_t* OB = (const bf16_t*)(C.ws + WS_OB); const bf16_t* PROJ = (const bf16_t*)(C.ws + WS_PROJ); bf16_t* CAT = (bf16_t*)(C.ws + WS_CAT);
    const f32x4 n0 = *(const f32x4*)(C.in[I_GNW] + 8 * l16), n1 = *(const f32x4*)(C.in[I_GNW] + 8 * l16 + 4);
    for (int it = it0 + grp; it < it1; it += ngrp) { const int m = it >> 2, h = it & 3; float o[8], z[8];
        unpack8(*(const u32x4*)(OB + (size_t)m * 512 + h * 128 + 8 * l16), o); unpack8(*(const u32x4*)(PROJ + (size_t)m * NPROJ + 2056 + h * 128 + 8 * l16), z);
        float ss = 0.f;
#pragma unroll
        for (int e = 0; e < 8; ++e) ss += o[e] * o[e];
        ss = sum16(ss); const float rstd = __builtin_amdgcn_rsqf(ss * (1.f / 128.f) + NORM_EPS);
#pragma unroll
        for (int e = 0; e < 8; ++e) o[e] = o[e] * rstd * (e < 4 ? n0[e & 3] : n1[e & 3]) * siluf(z[e]);
        *(u32x4*)(CAT + (size_t)m * D + 512 + h * 128 + 8 * l16) = pack8(o); }
}

#ifndef RW_EXP
#define RW_EXP 0
#endif
#ifndef RW_SKIP
#define RW_SKIP 0
#endif
struct RwRaw { u32x2 r, l, k, v, a, k2; };
constexpr size_t WS_RWX = WS_W_IN;
static_assert((size_t)128 * 64 * 2 * 32 * 8 <= (size_t)NPROJ * 1024 * 2, "rwkv exchange");
template <bool HALF> DI void rwkv_job(const Ctx& C, int seq, int hd, int half, bool dry) {
    const int tid = opaque_tid(), lane = tid & 63, w = C.wave;
    const bool prompt = seq < NBP; const int b = prompt ? seq : seq - NBP; const int start = prompt ? seq * SEQP : MP + b * SEQS; const int len = prompt ? SEQP : SEQS;
    const bf16_t* R = (const bf16_t*)(C.ws + WS_R); const bf16_t* Kb = (const bf16_t*)(C.ws + WS_K); bf16_t* Vb = (bf16_t*)(C.ws + WS_V);
    const bf16_t* LD = (const bf16_t*)(C.ws + WS_LD); const bf16_t* AA = (const bf16_t*)(C.ws + WS_AA);
    constexpr int TC = 32, ARR = TC * 64, BUFF = 7 * ARR + TC * 8 + 64;
    LAS float* L0 = (LAS float*)C.lds;
    const int nch = (len + TC - 1) / TC;
    if (w < 4) {
        const int cg = lane & 7; const int row = HALF ? (8 * w + (lane >> 3)) : 2 * (8 * w + (lane >> 3));
        f32x2 s[4], s1[4];
#pragma unroll
        for (int e = 0; e < 4; ++e) { s[e] = (f32x2){0.f, 0.f}; s1[e] = (f32x2){0.f, 0.f}; }
        if (!HALF && !prompt) { const float* s0 = C.in[I_RWKV] + ((size_t)(b * 16 + hd) * 64 + row) * 64 + 8 * cg;
#pragma unroll
            for (int e = 0; e < 4; ++e) { s[e] = *(const f32x2*)(s0 + 2 * e); s1[e] = *(const f32x2*)(s0 + 64 + 2 * e); } }
        LBAR();
        float sa = 0.f, sb = 0.f;
        if (!HALF) { const LAS float* a0p = L0 + 7 * ARR + TC * 8 + 8 * cg; const f32x4 a0 = *(const LAS f32x4*)a0p, a1 = *(const LAS f32x4*)(a0p + 4);
          const f32x2 A0 = {a0.x, a0.y}, A1 = {a0.z, a0.w}, A2 = {a1.x, a1.y}, A3 = {a1.z, a1.w};
          const f32x2 t0 = (s[0] * A0 + s[1] * A1) + (s[2] * A2 + s[3] * A3), t1 = (s1[0] * A0 + s1[1] * A1) + (s1[2] * A2 + s1[3] * A3);
          sa = sum8_dpp(t0.x + t0.y); sb = sum8_dpp(t1.x + t1.y); }
#pragma unroll 1
        for (int c = 0; c < nch; ++c) {
            const int ntok = (len - c * TC) < TC ? (len - c * TC) : TC;
            LAS float* B_ = L0 + (c & 1) * BUFF; LAS float* Wd = B_; LAS float* WA = B_ + ARR; LAS float* Bm = B_ + 2 * ARR; LAS float* Kp = B_ + 3 * ARR; LAS float* WR = B_ + 4 * ARR; LAS float* Vv = B_ + 5 * ARR; LAS float* Yv = B_ + 6 * ARR; LAS float* Sc = B_ + 7 * ARR;
#define RW_DECL(P) f32x4 P##w0, P##w1, P##a0, P##a1, P##b0, P##b1, P##k0, P##k1, P##r0, P##r1, P##sc; f32x2 P##vi;
#define RW_LOAD(P, t) { P##w0 = *(const LAS f32x4*)(Wd + (t) * 64 + 8 * cg); P##w1 = *(const LAS f32x4*)(Wd + (t) * 64 + 8 * cg + 4); P##a0 = *(const LAS f32x4*)(WA + (t) * 64 + 8 * cg); P##a1 = *(const LAS f32x4*)(WA + (t) * 64 + 8 * cg + 4); \
                P##b0 = *(const LAS f32x4*)(Bm + (t) * 64 + 8 * cg); P##b1 = *(const LAS f32x4*)(Bm + (t) * 64 + 8 * cg + 4); P##k0 = *(const LAS f32x4*)(Kp + (t) * 64 + 8 * cg); P##k1 = *(const LAS f32x4*)(Kp + (t) * 64 + 8 * cg + 4); \
                P##r0 = *(const LAS f32x4*)(WR + (t) * 64 + 8 * cg); P##r1 = *(const LAS f32x4*)(WR + (t) * 64 + 8 * cg + 4); P##sc = *(const LAS f32x4*)(Sc + (t) * 8); \
                if (HALF) { P##vi.x = Vv[(t) * 64 + row]; P##vi.y = 0.f; } else P##vi = *(const LAS f32x2*)(Vv + (t) * 64 + row); }
#define RW_STEP(P, t) { \
                const f32x2 A0 = {P##a0.x, P##a0.y}, A1 = {P##a0.z, P##a0.w}, A2 = {P##a1.x, P##a1.y}, A3 = {P##a1.z, P##a1.w}, R0 = {P##r0.x, P##r0.y}, R1 = {P##r0.z, P##r0.w}, R2 = {P##r1.x, P##r1.y}, R3 = {P##r1.z, P##r1.w}; \
                const f32x2 B0 = {P##b0.x, P##b0.y}, B1 = {P##b0.z, P##b0.w}, B2 = {P##b1.x, P##b1.y}, B3 = {P##b1.z, P##b1.w}, K0 = {P##k0.x, P##k0.y}, K1 = {P##k0.z, P##k0.w}, K2 = {P##k1.x, P##k1.y}, K3 = {P##k1.z, P##k1.w}; \
                const f32x2 W0 = {P##w0.x, P##w0.y}, W1 = {P##w0.z, P##w0.w}, W2 = {P##w1.x, P##w1.y}, W3 = {P##w1.z, P##w1.w}; \
                const f32x2 sa2 = (s[0] * A0 + s[1] * A1) + (s[2] * A2 + s[3] * A3), yw2 = (s[0] * R0 + s[1] * R1) + (s[2] * R2 + s[3] * R3); \
                const f32x2 sav = {sa, sa}, viv = {P##vi.x, P##vi.x}; \
                s[0] = s[0] * W0 + (sav * B0 + viv * K0); s[1] = s[1] * W1 + (sav * B1 + viv * K1); s[2] = s[2] * W2 + (sav * B2 + viv * K2); s[3] = s[3] * W3 + (sav * B3 + viv * K3); \
                if (HALF) { \
                    const float d2a = sum8_dpp(sa2.x + sa2.y), d1a = sum8_dpp(yw2.x + yw2.y); \
                    Yv[(t) * 64 + row] = d1a + sa * P##sc.z + P##vi.x * P##sc.w; \
                    sa = d2a + sa * P##sc.x + P##vi.x * P##sc.y; \
                } else { \
                    const f32x2 sb2 = (s1[0] * A0 + s1[1] * A1) + (s1[2] * A2 + s1[3] * A3), yx2 = (s1[0] * R0 + s1[1] * R1) + (s1[2] * R2 + s1[3] * R3); \
                    const f32x2 sbv = {sb, sb}, vjv = {P##vi.y, P##vi.y}; \
                    s1[0] = s1[0] * W0 + (sbv * B0 + vjv * K0); s1[1] = s1[1] * W1 + (sbv * B1 + vjv * K1); s1[2] = s1[2] * W2 + (sbv * B2 + vjv * K2); s1[3] = s1[3] * W3 + (sbv * B3 + vjv * K3); \
                    const float d2a = sum8_dpp(sa2.x + sa2.y), d2b = sum8_dpp(sb2.x + sb2.y), d1a = sum8_dpp(yw2.x + yw2.y), d1b = sum8_dpp(yx2.x + yx2.y); \
                    *(LAS f32x2*)(Yv + (t) * 64 + row) = (f32x2){d1a + sa * P##sc.z + P##vi.x * P##sc.w, d1b + sb * P##sc.z + P##vi.y * P##sc.w}; \
                    sa = d2a + sa * P##sc.x + P##vi.x * P##sc.y; sb = d2b + sb * P##sc.x + P##vi.y * P##sc.y; } }
            RW_DECL(p) RW_DECL(n) RW_DECL(p2) RW_DECL(n2)
            RW_LOAD(p, 0) RW_LOAD(n, 1)
            for (int t = 0; t < ntok; t += 4) {
                RW_LOAD(p2, t + 2) RW_LOAD(n2, t + 3)
                RW_STEP(p, t) RW_STEP(n, t + 1)
                RW_LOAD(p, t + 4) RW_LOAD(n, t + 5)
                RW_STEP(p2, t + 2) RW_STEP(n2, t + 3)
            }
#undef RW_DECL
#undef RW_LOAD
#undef RW_STEP
            LBAR();
        }
        if (!dry) { float* so = C.out + (prompt ? O_P_RWKV : O_S_RWKV) + ((size_t)(b * 16 + hd) * 64 + half * 32 + row) * 64 + 8 * cg;
#pragma unroll
            for (int e = 0; e < 4; ++e) { *(f32x2*)(so + 2 * e) = s[e]; if (!HALF) *(f32x2*)(so + 64 + 2 * e) = s1[e]; } }
    } else {
        const int bt = tid - 256, tl0 = bt >> 4, l16 = bt & 15, ch = hd * 64 + 4 * l16;
        const f32x4 kkw = *(const f32x4*)(C.in[I_KK] + ch), kaw = *(const f32x4*)(C.in[I_KA] + ch), rkw = *(const f32x4*)(C.in[I_RK] + ch);
        const bool pact = !HALF || l16 < 8; const int pch = hd * 64 + half * 32 + 4 * l16;
        f32x4 lnw = {0.f, 0.f, 0.f, 0.f}, lnb = {0.f, 0.f, 0.f, 0.f};
        if (pact) { lnw = *(const f32x4*)(C.in[I_LNW] + pch); lnb = *(const f32x4*)(C.in[I_LNB] + pch); }
        float* xb = (float*)(C.ws + WS_RWX) + (size_t)(seq * 16 + hd) * (64 * 2 * 32 * 2);
        RwRaw raw[2];
        auto load_raw = [&](int c) {
#pragma unroll
            for (int hh = 0; hh < 2; ++hh) { const int t = c * TC + tl0 + 16 * hh; RwRaw z; z.r = z.l = z.k = z.v = z.a = z.k2 = (u32x2){0u, 0u};
                if (t < len) { const size_t off = (size_t)(start + t) * D + ch; z.r = *(const u32x2*)(R + off); z.l = *(const u32x2*)(LD + off); z.k = *(const u32x2*)(Kb + off); z.v = *(const u32x2*)(Vb + off); z.a = *(const u32x2*)(AA + off);
                    if (t + 1 < len) z.k2 = *(const u32x2*)(Kb + off + D); }
                raw[hh] = z; } };
        auto prep = [&](int c) {
            LAS float* B_ = L0 + (c & 1) * BUFF;
#pragma unroll
            for (int hh = 0; hh < 2; ++hh) { const int tl = tl0 + 16 * hh; const RwRaw z = raw[hh];
                const float rr[4] = {bf_lo(z.r.x), bf_hi(z.r.x), bf_lo(z.r.y), bf_hi(z.r.y)}; const float wd[4] = {__expf(bf_lo(z.l.x)), __expf(bf_hi(z.l.x)), __expf(bf_lo(z.l.y)), __expf(bf_hi(z.l.y))};
                const float kr_[4] = {bf_lo(z.k.x), bf_hi(z.k.x), bf_lo(z.k.y), bf_hi(z.k.y)}; const float vv[4] = {bf_lo(z.v.x), bf_hi(z.v.x), bf_lo(z.v.y), bf_hi(z.v.y)}; const float aa[4] = {bf_lo(z.a.x), bf_hi(z.a.x), bf_lo(z.a.y), bf_hi(z.a.y)};
                const float kn_[4] = {bf_lo(z.k2.x), bf_hi(z.k2.x), bf_lo(z.k2.y), bf_hi(z.k2.y)};
                float kk[4], kp[4], k2[4], ss = 0.f, ss2 = 0.f;
#pragma unroll
                for (int e = 0; e < 4; ++e) { kk[e] = kr_[e] * kkw[e]; ss += kk[e] * kk[e]; kp[e] = kr_[e] * (1.f + (aa[e] - 1.f) * kaw[e]); k2[e] = kn_[e] * kkw[e]; ss2 += k2[e] * k2[e]; }
                ss = sum16(ss); ss2 = sum16(ss2); const float rs = __builtin_amdgcn_rsqf(ss + NORM_EPS), rs2 = __builtin_amdgcn_rsqf(ss2 + NORM_EPS);
                float br = 0.f, kr = 0.f, bo = 0.f, ga = 0.f, de = 0.f; f32x4 am, an, bm, wr4, wa4, kp4, wd4, vv4;
#pragma unroll
                for (int e = 0; e < 4; ++e) { const float kn = kk[e] * rs; am[e] = -kn; an[e] = -k2[e] * rs2; bm[e] = kn * aa[e]; wr4[e] = wd[e] * rr[e]; wa4[e] = wd[e] * an[e]; kp4[e] = kp[e]; wd4[e] = wd[e]; vv4[e] = vv[e];
                    br += bm[e] * rr[e]; kr += kp[e] * rr[e]; bo += rr[e] * kp[e] * rkw[e]; ga += bm[e] * an[e]; de += kp[e] * an[e]; }
                br = sum16(br); kr = sum16(kr); bo = sum16(bo); ga = sum16(ga); de = sum16(de);
                *(LAS f32x4*)(B_ + tl * 64 + 4 * l16) = wd4; *(LAS f32x4*)(B_ + ARR + tl * 64 + 4 * l16) = wa4; *(LAS f32x4*)(B_ + 2 * ARR + tl * 64 + 4 * l16) = bm;
                *(LAS f32x4*)(B_ + 3 * ARR + tl * 64 + 4 * l16) = kp4; *(LAS f32x4*)(B_ + 4 * ARR + tl * 64 + 4 * l16) = wr4;
                if (!HALF) *(LAS f32x4*)(B_ + 5 * ARR + tl * 64 + 4 * l16) = vv4;
                else if ((l16 >> 3) == half) *(LAS f32x4*)(B_ + 5 * ARR + tl * 64 + 4 * (l16 & 7)) = vv4;
                if (l16 == 0) { *(LAS f32x4*)(B_ + 7 * ARR + tl * 8) = (f32x4){ga, de, br, kr}; B_[7 * ARR + tl * 8 + 4] = bo; }
                if (tl == 0) *(LAS f32x4*)(B_ + 7 * ARR + TC * 8 + 4 * l16) = am; } };
        struct PostRegs { float y[2][4], v[2][4], bo[2], sum[2], sq[2]; };
        PostRegs cur, prev;
        auto post1 = [&](int c, PostRegs& P) {
            LAS float* B_ = L0 + (c & 1) * BUFF; const int ntok = (len - c * TC) < TC ? (len - c * TC) : TC;
#pragma unroll
            for (int hh = 0; hh < 2; ++hh) { const int tl = tl0 + 16 * hh;
#pragma unroll
                for (int e = 0; e < 4; ++e) { P.y[hh][e] = 0.f; P.v[hh][e] = 0.f; }
                P.bo[hh] = 0.f;
                if (tl < ntok && pact) { const f32x4 yv = *(const LAS f32x4*)(B_ + 6 * ARR + tl * 64 + 4 * l16), v4 = *(const LAS f32x4*)(B_ + 5 * ARR + tl * 64 + 4 * l16); P.bo[hh] = B_[7 * ARR + tl * 8 + 4];
#pragma unroll
                    for (int e = 0; e < 4; ++e) { P.y[hh][e] = yv[e]; P.v[hh][e] = v4[e]; } }
                P.sum[hh] = sum16((P.y[hh][0] + P.y[hh][1]) + (P.y[hh][2] + P.y[hh][3]));
                P.sq[hh] = sum16((P.y[hh][0] * P.y[hh][0] + P.y[hh][1] * P.y[hh][1]) + (P.y[hh][2] * P.y[hh][2] + P.y[hh][3] * P.y[hh][3]));
                if (HALF && l16 == 0) { unsigned long long* slot = (unsigned long long*)(xb + ((size_t)(c * 2 + half) * 32 + tl) * 2);
                    __hip_atomic_store(slot, ((unsigned long long)__float_as_uint(P.sq[hh]) << 32) | __float_as_uint(P.sum[hh]), __ATOMIC_RELAXED, __HIP_MEMORY_SCOPE_AGENT); } } };
        auto load_px = [&](int c, unsigned long long (&px)[2]) {
#pragma unroll
            for (int hh = 0; hh < 2; ++hh) px[hh] = __hip_atomic_load((const unsigned long long*)(xb + ((size_t)(c * 2 + (half ^ 1)) * 32 + tl0 + 16 * hh) * 2), __ATOMIC_RELAXED, __HIP_MEMORY_SCOPE_AGENT); };
        auto post2 = [&](int c, const PostRegs& P, unsigned long long (&px)[2]) {
            const int ntok = (len - c * TC) < TC ? (len - c * TC) : TC;
#pragma unroll
            for (int hh = 0; hh < 2; ++hh) { const int tl = tl0 + 16 * hh; float tsum = P.sum[hh], tsq = P.sq[hh];
                if (HALF) { unsigned sp = 0;
                    while (px[hh] == ~0ull) { __builtin_amdgcn_s_sleep(1); px[hh] = __hip_atomic_load((const unsigned long long*)(xb + ((size_t)(c * 2 + (half ^ 1)) * 32 + tl) * 2), __ATOMIC_RELAXED, __HIP_MEMORY_SCOPE_AGENT); if (++sp > (1u << 20)) break; }
                    tsum += __uint_as_float((unsigned)px[hh]); tsq += __uint_as_float((unsigned)(px[hh] >> 32)); }
                const float mu = tsum * (1.f / 64.f); const float var = fmaxf(tsq * (1.f / 64.f) - mu * mu, 0.f); const float rstd = __builtin_amdgcn_rsqf(var + 64e-5f);
                if (tl < ntok && pact && !dry) { float o[4];
#pragma unroll
                    for (int e = 0; e < 4; ++e) o[e] = (P.y[hh][e] - mu) * rstd * lnw[e] + lnb[e] + P.bo[hh] * P.v[hh][e];
                    u32x2 pk; pk.x = pk2(o[0], o[1]); pk.y = pk2(o[2], o[3]); *(u32x2*)(Vb + (size_t)(start + c * TC + tl) * D + pch) = pk; } } };
        unsigned long long px[2] = {0ull, 0ull};
        load_raw(0); prep(0); load_raw(1);
        LBAR();
#pragma unroll 1
        for (int c = 0; c < nch; ++c) {
            if (HALF && c >= 2) load_px(c - 2, px);
            if (c >= 1) post1(c - 1, cur);
            if (c + 1 < nch) prep(c + 1);
            if (HALF) { if (c >= 2) post2(c - 2, prev, px); } else { if (c >= 1) post2(c - 1, cur, px); }
            if (c + 1 < nch) load_raw(c + 2);
            prev = cur;
            LBAR();
        }
        if (HALF) { if (nch >= 2) load_px(nch - 2, px);
            post1(nch - 1, cur);
            if (nch >= 2) post2(nch - 2, prev, px);
            load_px(nch - 1, px); post2(nch - 1, cur, px); }
        else { post1(nch - 1, cur); post2(nch - 1, cur, px); }
    }
    LBAR();
}

constexpr size_t WS_BAR = 59 * MiB;
static_assert(WS_W_END <= WS_BAR, "barrier words");
#define XB_TMO      128
#define XB_XCNT(j)  (256  + 64 * (j))
#define XB_XSUB(j)  (1280 + 64 * (j))
#define XB_XGEN(j)  (2304 + 64 * (j))
#define XB_TOP      3328
#define XB_TOPGEN   3392
#define XCD_BAR_WORDS 3456
#define XB_SPIN_CAP (1u << 20)
DI unsigned xb_ld(unsigned* p)              { return __hip_atomic_load(p, __ATOMIC_RELAXED, __HIP_MEMORY_SCOPE_AGENT); }
DI unsigned xb_add(unsigned* p, unsigned v) { return __hip_atomic_fetch_add(p, v, __ATOMIC_RELAXED, __HIP_MEMORY_SCOPE_AGENT); }
DI unsigned xb_xcc_id() { return (unsigned)__builtin_amdgcn_s_getreg((3 << 11) | 20) & 0xFu; }
#define XB_SPIN(cond, bar) do { unsigned _sp = 0; while (cond) { __builtin_amdgcn_s_sleep(1); \
    if ((++_sp & 255u) == 0u) { if (xb_ld(&(bar)[XB_TMO])) break; if (_sp > XB_SPIN_CAP) { atomicAdd(&(bar)[XB_TMO], 1u); break; } } } } while (0)
struct XcdBarrier { unsigned* bar; unsigned x; volatile LAS unsigned* st; };
DI XcdBarrier xcd_barrier_post(unsigned* bar, volatile LAS unsigned* st) {
    XcdBarrier b; b.bar = bar; b.x = xb_xcc_id(); b.st = st;
    if (threadIdx.x == 0) (void)xb_add(&bar[XB_XCNT(b.x)], 1u);
    return b;
}
DI void xcd_barrier_complete(unsigned* bar, unsigned x, unsigned& nloc, unsigned& nx) {
    const unsigned G = gridDim.x * gridDim.y * gridDim.z;
    unsigned sum, cnt, mine, sp = 0u;
    for (;;) {
        sum = 0u; cnt = 0u; mine = 0u;
#pragma unroll
        for (unsigned j = 0; j < 16; ++j) { const unsigned c = xb_ld(&bar[XB_XCNT(j)]); sum += c; cnt += (c > 0u) ? 1u : 0u; mine = (j == x) ? c : mine; }
        if (sum == G) break;
        __builtin_amdgcn_s_sleep(1);
        if ((++sp & 255u) == 0u) { if (xb_ld(&bar[XB_TMO])) break; if (sp > XB_SPIN_CAP) { atomicAdd(&bar[XB_TMO], 1u); break; } }
    }
    nloc = mine > 0u ? mine : 1u; nx = cnt > 0u ? cnt : 1u;
}
DI void xcd_barrier(const XcdBarrier& b) {
    asm volatile("s_waitcnt vmcnt(0)" ::: "memory");
    __syncthreads();
    if (threadIdx.x == 0) {
        unsigned* bar = b.bar;
        __builtin_amdgcn_s_waitcnt(0);
        unsigned nloc = b.st[0], nx = b.st[1];
        if (nloc == 0u) { xcd_barrier_complete(bar, b.x, nloc, nx); b.st[0] = nloc; b.st[1] = nx; }
        const unsigned old = xb_add(&bar[XB_XSUB(b.x)], 1u);
        const unsigned gen = old / nloc;
        if (old + 1u == (gen + 1u) * nloc) {
            __builtin_amdgcn_fence(__ATOMIC_RELEASE, "agent");
            asm volatile("s_waitcnt vmcnt(0)" ::: "memory");
            const unsigned og = xb_add(&bar[XB_TOP], 1u);
            const unsigned tg = og / nx;
            if (og + 1u == (tg + 1u) * nx) xb_add(&bar[XB_TOPGEN], 1u);
            else XB_SPIN(xb_ld(&bar[XB_TOPGEN]) == tg, bar);
            __builtin_amdgcn_fence(__ATOMIC_ACQUIRE, "agent");
            xb_add(&bar[XB_XGEN(b.x)], 1u);
            asm volatile("s_waitcnt vmcnt(0)" ::: "memory");
        } else {
            XB_SPIN(xb_ld(&bar[XB_XGEN(b.x)]) == gen, bar);
            __builtin_amdgcn_fence(__ATOMIC_ACQUIRE, "agent");
            asm volatile("s_waitcnt vmcnt(0)" ::: "memory");
        }
    }
    __syncthreads();
}

#ifndef PH_MASK
#define PH_MASK 0xFFFFFFFFu
#endif
#define PH(k) ((PH_MASK >> (k)) & 1u)
#ifndef REP_MASK
#define REP_MASK 0u
#endif
#ifndef NSYNC_EXTRA
#define NSYNC_EXTRA 0
#endif
#define REP(k) ((REP_MASK >> (k)) & 1u)
#define PHASE(k, ...) _Pragma("unroll 1") for (int rep_ = 0; rep_ <= (int)REP(k); ++rep_) { if (PH(k)) { __VA_ARGS__ } GSYNC(); }
#define PHASE1(k, ...) { if (PH(k)) { __VA_ARGS__ } GSYNC(); }
#define GSYNC() xcd_barrier(xbar)
#define PHASED(k, ...) _Pragma("unroll 1") for (int rep_ = 0; rep_ <= (int)REP(k); ++rep_) { const int dry_ = rep_ < (int)REP(k); if (PH(k)) { __VA_ARGS__ } GSYNC(); }
template <int MODE> DI void run_gemm(const Ctx& C, const bf16_t* A, int lda, const bf16_t* Bt, int ldb, int N, int K, const Epi<MODE>& E, int split = 0, int Mrows = M) {
    pg8::Gemm g{A, Bt, Mrows, N, K, lda, ldb}; pg8::StaticOrder S; S.init(Mrows, N, C.G, C.blk, K, split);
    pg8::gemm_phase<Epi<MODE>, true, MODE == EP_ATOM>(C.lds, g, S, E);
}

__global__ void __launch_bounds__(512, 2) fwd_megakernel(Args args) {
    extern __shared__ __attribute__((aligned(16))) unsigned char lds_raw[];
    cg::grid_group grid = cg::this_grid();
    Ctx C; C.in = args.in; C.out = args.out; C.ws = args.ws; C.lds = (LAS unsigned char*)lds_raw;
    C.tid = threadIdx.x; C.lane = C.tid & 63; C.wave = __builtin_amdgcn_readfirstlane(C.tid >> 6); C.G = gridDim.x; C.blk = blockIdx.x;
    unsigned char* ws = args.ws;
    bf16_t* W_IN = (bf16_t*)(ws + WS_W_IN); bf16_t* W_GLU = (bf16_t*)(ws + WS_W_GLU); bf16_t* W_OUT = (bf16_t*)(ws + WS_W_OUT);
    bf16_t* W_GU0 = (bf16_t*)(ws + WS_W_GU0); bf16_t* W_DN0 = (bf16_t*)(ws + WS_W_DN0); bf16_t* W_GU1 = (bf16_t*)(ws + WS_W_GU1); bf16_t* W_DN1 = (bf16_t*)(ws + WS_W_DN1);
    bf16_t* W_RW1 = (bf16_t*)(ws + WS_W_RW1); bf16_t* W_RW2 = (bf16_t*)(ws + WS_W_RW2); bf16_t* W_G2 = (bf16_t*)(ws + WS_W_G2); bf16_t* W_O = (bf16_t*)(ws + WS_W_O);
    bf16_t* HB = (bf16_t*)(ws + WS_HB); bf16_t* PROJ = (bf16_t*)(ws + WS_PROJ); bf16_t* CAT = (bf16_t*)(ws + WS_CAT);
    bf16_t* Rb = (bf16_t*)(ws + WS_R); bf16_t* Kb = (bf16_t*)(ws + WS_K); bf16_t* Vb = (bf16_t*)(ws + WS_V); bf16_t* LDb = (bf16_t*)(ws + WS_LD); bf16_t* AAb = (bf16_t*)(ws + WS_AA);
    bf16_t* LMWA = (bf16_t*)(ws + WS_LMWA); bf16_t* LMG = (bf16_t*)(ws + WS_LMG);
    float* X = args.out + O_Y;
    volatile LAS unsigned* xst = (volatile LAS unsigned*)(C.lds + (LDS_BYTES - 64));
    if (C.tid < 16) xst[C.tid] = 0u;
    __syncthreads();
    const XcdBarrier xbar = xcd_barrier_post((unsigned*)(ws + WS_BAR), xst);
    const bool RS_SPLIT = (C.G == 256); const int RS_M = RS_SPLIT ? MP : M;
    if (args.ws == nullptr) grid.sync();

    PHASE(0,
    tr_all(C, 0, 1, 0);
    zero_rect(C, W_IN, 1024, 2568, NPROJ - 2568, 0, 1024);
    rms_rows<0>(C, C.in[I_XP], C.in[I_XS], C.in[I_NMIX], HB);
    )
    PHASE(1, Epi<EP_BF16> E{}; E.O = PROJ; E.ldo = NPROJ; run_gemm<EP_BF16>(C, HB, 1024, W_IN, 1024, NPROJ, 1024, E); )
    PHASE(2,
    if (PH(20)) for (int j = C.blk; j < 1024 + NBS * 4; j += C.G) { if (j < 1024) gdn_unit(C, j >> 7, ((j >> 2) & 31) * 64, j & 3); else gdn_unit(C, NBP + ((j - 1024) >> 2), 0, j & 3); }
    __syncthreads();
    if (PH(21)) for (int j = C.blk * 8 + C.wave; j < NBS * 32 + 2048; j += C.G * 8) { if (j < NBS * 32) s5_unit<2>(C, NBP + (j >> 5), j & 31, 0); else { const int k = j - NBS * 32; s5_unit<1>(C, k >> 8, (k >> 3) & 31, k & 7); } }
    )
    PHASE(18,
    if (C.blk < 64) { if (PH(20)) gdn_seq(C, C.blk >> 3, (C.blk >> 1) & 3, C.blk & 1); }
    else { if (PH(21)) for (int k = (C.blk - 64) * 8 + C.wave; k < 2048; k += (C.G - 64) * 8) s5_unit<2>(C, k >> 8, (k >> 3) & 31, k & 7); }
    if (C.blk >= 64 && rep_ == 0) { __syncthreads();
        tr_all(C, 1, NTJ, 64);
        zero_rect(C, W_RW1, 2048, 3200, 128, 0, 2048, 64);
        zero_rect(C, W_RW1, 2048, 3488, 96, 0, 2048, 64);
        zero_rect(C, W_RW2, 128, 0, 1024, 64, 64, 64);
        zero_rect(C, W_RW2, 128, 1024, 1024, 0, 64, 64);
        zero_rect(C, W_G2, 256, 0, 1024, 192, 64, 64); }
    )
    PHASE(3, constexpr int GP1 = 37632;
        if (C.blk >= 136) gdn_post(C, 136, 0, GP1); else { Epi<EP_GLU> E{}; E.O = CAT; E.ldo = D; E.X = (const bf16_t*)(ws + WS_YG); E.ldx = 512; run_gemm<EP_GLU>(C, (const bf16_t*)(ws + WS_YG), 512, W_GLU, 512, 512, 512, E); } gdn_post(C, 0, GP1, M * 4); )
    PHASE(4, Epi<EP_RESID> E{}; E.baseP = C.in[I_XP]; E.baseS = C.in[I_XS]; E.out = X; run_gemm<EP_RESID>(C, CAT, D, W_OUT, 1024, 1024, 1024, E, 0, RS_M); if (RS_SPLIT) { Epi<EP_ATOM> E2{}; E2.out = (float*)(ws + WS_PROJ); E2.dry = E.dry; run_gemm<EP_ATOM>(C, CAT, D, W_OUT, 1024, 1024, 1024, E2, 8, M); } )
    PHASE(5, rms_rows<0>(C, X, X + (size_t)MP * D, C.in[I_NFFN], HB, RS_SPLIT ? (const float*)(ws + WS_PROJ) : nullptr, 8, C.in[I_XS]); )
    PHASE(6, Epi<EP_SWIGLU> E{}; E.O = PROJ; E.ldo = DFF; run_gemm<EP_SWIGLU>(C, HB, 1024, W_GU0, 1024, 2 * DFF, 1024, E); )
    PHASED(7, Epi<EP_RESID> E{}; E.dry = dry_; E.baseP = X; E.baseS = X + (size_t)MP * D; E.out = X; run_gemm<EP_RESID>(C, PROJ, DFF, W_DN0, DFF, 1024, DFF, E, 0, RS_M); if (RS_SPLIT) { Epi<EP_ATOM> E2{}; E2.out = (float*)(ws + WS_CAT); E2.dry = E.dry; run_gemm<EP_ATOM>(C, PROJ, DFF, W_DN0, DFF, 1024, DFF, E2, 11, M); } )
    PHASE(8, rms_rows<1>(C, X, X + (size_t)MP * D, C.in[I_NMIX] + D, HB, RS_SPLIT ? (const float*)(ws + WS_CAT) : nullptr, 11, X + (size_t)MP * D);
        for (int e = C.blk * 512 + C.tid; e < 128 * 64 * 2 * 32 * 8 / 16; e += C.G * 512) *(u32x4*)(ws + WS_RWX + (size_t)e * 16) = (u32x4){~0u, ~0u, ~0u, ~0u}; )
    PHASE(9, Epi<EP_RW1> E{}; E.O = Rb; E.O4 = LMWA; E.O5 = LMG; run_gemm<EP_RW1>(C, HB, 2048, W_RW1, 2048, NRW1, 2048, E); )
    PHASE(10, Epi<EP_RW2> E{}; E.O = LDb; E.v0 = C.in[I_W0]; E.v1 = C.in[I_A0]; run_gemm<EP_RW2>(C, LMWA, 128, W_RW2, 128, 2048, 128, E); )
    PHASED(11,
    for (int j = C.blk; j < NBS * 16; j += C.G) rwkv_job<false>(C, NBP + (j >> 4), j & 15, 0, dry_);
    rwkv_job<true>(C, C.blk >> 5, (C.blk >> 1) & 15, C.blk & 1, dry_);
    )
    PHASED(12, Epi<EP_GATE> E{}; E.dry = dry_; E.O = Vb; E.ldo = D; run_gemm<EP_GATE>(C, LMG, 256, W_G2, 256, 1024, 256, E); )
    PHASED(13, Epi<EP_RESID> E{}; E.dry = dry_; E.baseP = X; E.baseS = X + (size_t)MP * D; E.out = X; run_gemm<EP_RESID>(C, Vb, D, W_O, 1024, 1024, 1024, E, 0, RS_M); if (RS_SPLIT) { Epi<EP_ATOM> E2{}; E2.out = (float*)(ws + WS_AA); E2.dry = E.dry; run_gemm<EP_ATOM>(C, Vb, D, W_O, 1024, 1024, 1024, E2, 8, M); } )
    PHASE(14, rms_rows<0>(C, X, X + (size_t)MP * D, C.in[I_NFFN] + D, HB, RS_SPLIT ? (const float*)(ws + WS_AA) : nullptr, 8, X + (size_t)MP * D); )
    PHASE(15, Epi<EP_SWIGLU> E{}; E.O = PROJ; E.ldo = DFF; run_gemm<EP_SWIGLU>(C, HB, 1024, W_GU1, 1024, 2 * DFF, 1024, E); )
    PHASED(16, Epi<EP_RESID> E{}; E.dry = dry_; E.baseP = X; E.baseS = X + (size_t)MP * D; E.out = X; run_gemm<EP_RESID>(C, PROJ, DFF, W_DN1, DFF, 1024, DFF, E, 0, RS_M); if (RS_SPLIT) { Epi<EP_ATOM> E2{}; E2.out = (float*)(ws + WS_CAT); E2.dry = E.dry; run_gemm<EP_ATOM>(C, PROJ, DFF, W_DN1, DFF, 1024, DFF, E2, 11, M); } )
    for (int xs = 0; xs < NSYNC_EXTRA; ++xs) GSYNC();
    if (PH(17)) rms_rows<2>(C, X, X + (size_t)MP * D, C.in[I_NFIN], nullptr, RS_SPLIT ? (const float*)(ws + WS_CAT) : nullptr, 11, X + (size_t)MP * D);
}

extern "C" void kernel_launch(void* const* d_in, const int* in_sizes, int n_in, void* d_out, int out_size, void* d_ws, size_t ws_size, hipStream_t stream) {
    static int grid = 0;
    if (grid == 0) {
        if (n_in != 47 || (size_t)out_size != O_END || ws_size < WS_END) { fprintf(stderr, "kernel_launch: unexpected shapes n_in %d out %d ws %zu\n", n_in, out_size, ws_size); grid = -1; return; }
        int dev = 0, cus = 0, per_cu = 0;
        hipGetDevice(&dev); hipDeviceGetAttribute(&cus, hipDeviceAttributeMultiprocessorCount, dev);
        hipFuncSetAttribute((const void*)fwd_megakernel, hipFuncAttributeMaxDynamicSharedMemorySize, LDS_BYTES);
        hipOccupancyMaxActiveBlocksPerMultiprocessor(&per_cu, (const void*)fwd_megakernel, 512, LDS_BYTES);
        (void)hipGetLastError();
        if (per_cu < 1) { fprintf(stderr, "kernel_launch: occupancy query says %d blocks per CU\n", per_cu); per_cu = 1; }
        grid = cus;
    }
    if (grid < 0) return;
    if (hipMemsetAsync((char*)d_ws + WS_BAR, 0, XCD_BAR_WORDS * 4, stream) != hipSuccess) { fprintf(stderr, "kernel_launch: memset of the barrier words failed\n"); return; }
    Args a{};
    for (int i = 0; i < 47; ++i) a.in[i] = (const float*)d_in[i];
    a.out = (float*)d_out; a.ws = (unsigned char*)d_ws;
    void* kargs[] = {&a};
    hipError_t e = hipLaunchCooperativeKernel((const void*)fwd_megakernel, dim3(grid), dim3(512), kargs, LDS_BYTES, stream);
    if (e != hipSuccess) fprintf(stderr, "cooperative launch failed: %s (grid %d)\n", hipGetErrorString(e), grid);
}
```
